# Optimizing an MI355X kernel written in HIP

```python
import math
import jax, jax.numpy as jnp
from jax import lax
import numpy as np

D_MODEL = 1024
BATCH = 2
SEQ = 8192
DEPTH = 2

N_MIXERS = 2
D_INNER = 2 * D_MODEL
RET_HEADS = 4
RET_QK_DIM = D_MODEL // RET_HEADS
RET_V_DIM = D_INNER // RET_HEADS
RET_CHUNK = 128
RET_IN_COLS = 2 * RET_HEADS * RET_QK_DIM + 2 * D_INNER
DIFF_HEADS = 16
DIFF_HEAD_DIM = D_INNER // DIFF_HEADS // 2
DIFF_V_DIM = 2 * DIFF_HEAD_DIM
Q_BLOCK = 128
DIFF_IN_COLS = 3 * DIFF_HEADS * 2 * DIFF_HEAD_DIM + D_INNER
REL_BUCKETS = 32
REL_MAX_DIST = 128
ROPE_BASE = 10000.0
RMS_EPS = 1e-6
GN_EPS = 1e-5

N_RET_LAYERS = (DEPTH + 1) // 2
N_DIFF_LAYERS = DEPTH // 2

kernel_name = "hybrid_retention_diffattn_trunk"


def rmsnorm(x, g, eps=RMS_EPS):
    xf = x.astype(jnp.float32)
    y = xf * lax.rsqrt(jnp.mean(xf * xf, axis=-1, keepdims=True) + eps)
    return (y * g.astype(jnp.float32)).astype(x.dtype)


def rope(x, pos):
    half = x.shape[-1] // 2
    inv = ROPE_BASE ** (-jnp.arange(half, dtype=jnp.float32) / half)
    ang = pos[:, None] * inv[None, :]
    c, s = jnp.cos(ang), jnp.sin(ang)
    x1, x2 = x[..., :half], x[..., half:]
    return jnp.concatenate([x1 * c - x2 * s, x1 * s + x2 * c], axis=-1)


def retention_mixer(h, w_in, w_out):
    B, S, _ = h.shape
    H, dk, dv, C = RET_HEADS, RET_QK_DIM, RET_V_DIM, RET_CHUNK
    N = S // C
    proj = h @ w_in
    qw = H * dk
    q, k, v, g = jnp.split(proj, [qw, 2 * qw, 2 * qw + D_INNER], axis=-1)
    q = q.reshape(B, S, H, dk).transpose(0, 2, 1, 3).astype(jnp.float32)
    k = k.reshape(B, S, H, dk).transpose(0, 2, 1, 3).astype(jnp.float32)
    v = v.reshape(B, S, H, dv).transpose(0, 2, 1, 3).astype(jnp.float32)
    pos = jnp.arange(S, dtype=jnp.float32)
    q = rope(q, pos)
    k = rope(k, pos) * (dk ** -0.5)
    log_gamma = jnp.log1p(-jnp.exp2(-5.0 - jnp.arange(H, dtype=jnp.float32)))
    idx = jnp.arange(C, dtype=jnp.float32)
    rel = idx[:, None] - idx[None, :]
    dmat = jnp.exp(log_gamma[:, None, None] * jnp.maximum(rel, 0.0)) * (rel >= 0)
    xi = jnp.exp(log_gamma[:, None] * (idx + 1.0))
    zeta = jnp.exp(log_gamma[:, None] * (C - 1.0 - idx))
    chunk_decay = jnp.exp(log_gamma * C)
    qc = q.reshape(B, H, N, C, dk)
    kc = k.reshape(B, H, N, C, dk)
    vc = v.reshape(B, H, N, C, dv)
    scores = jnp.einsum('bhncd,bhnmd->bhncm', qc, kc) * dmat[None, :, None]
    inner = jnp.einsum('bhncm,bhnme->bhnce', scores, vc)

    def step(R, xs):
        qn, kn, vn = xs
        cross = jnp.einsum('bhcd,bhde->bhce', qn, R) * xi[None, :, :, None]
        R_new = R * chunk_decay[None, :, None, None] + jnp.einsum(
            'bhcd,bhce->bhde', kn, vn * zeta[None, :, :, None])
        return R_new, cross

    R0 = jnp.zeros((B, H, dk, dv), jnp.float32)
    xs = (qc.transpose(2, 0, 1, 3, 4), kc.transpose(2, 0, 1, 3, 4), vc.transpose(2, 0, 1, 3, 4))
    _, cross = lax.scan(step, R0, xs)
    ret = (inner + cross.transpose(1, 2, 0, 3, 4)).reshape(B, H, S, dv)
    mu = jnp.mean(ret, axis=-1, keepdims=True)
    var = jnp.mean(jnp.square(ret - mu), axis=-1, keepdims=True)
    ret = (ret - mu) * lax.rsqrt(var + GN_EPS)
    y = ret.transpose(0, 2, 1, 3).reshape(B, S, D_INNER)
    gated = jax.nn.silu(g.astype(jnp.float32)) * y
    return gated.astype(w_out.dtype) @ w_out


def t5_bucket(q_pos, k_pos):
    n = jnp.maximum(q_pos[:, None] - k_pos[None, :], 0)
    max_exact = REL_BUCKETS // 2
    nf = jnp.maximum(n, max_exact).astype(jnp.float32)
    large = max_exact + (jnp.log(nf / max_exact) / math.log(REL_MAX_DIST / max_exact)
                         * (REL_BUCKETS - max_exact)).astype(jnp.int32)
    large = jnp.minimum(large, REL_BUCKETS - 1)
    return jnp.where(n < max_exact, n, large)


def diff_attn_mixer(h, w_in, w_out, lq1, lk1, lq2, lk2, subln_g, rel_bias, lambda_init):
    B, S, _ = h.shape
    H, d, dv = DIFF_HEADS, DIFF_HEAD_DIM, DIFF_V_DIM
    proj = h @ w_in
    qw = H * 2 * d
    q, k, v, g = jnp.split(proj, [qw, 2 * qw, 2 * qw + H * dv], axis=-1)
    q = q.reshape(B, S, H, 2, d).transpose(0, 2, 3, 1, 4).astype(jnp.float32) * (d ** -0.5)
    k = k.reshape(B, S, H, 2, d).transpose(0, 2, 3, 1, 4).astype(jnp.float32)
    v = v.reshape(B, S, H, dv).transpose(0, 2, 1, 3).astype(jnp.float32)
    lam = (jnp.exp(jnp.sum(lq1.astype(jnp.float32) * lk1.astype(jnp.float32)))
           - jnp.exp(jnp.sum(lq2.astype(jnp.float32) * lk2.astype(jnp.float32)))
           + lambda_init)
    NB = S // Q_BLOCK
    qb = q.reshape(B, H, 2, NB, Q_BLOCK, d).transpose(3, 0, 1, 2, 4, 5)
    starts = jnp.arange(NB, dtype=jnp.int32) * Q_BLOCK
    k_pos = jnp.arange(S, dtype=jnp.int32)
    table = rel_bias.astype(jnp.float32)

    def block(args):
        qblk, start = args
        q_pos = start + jnp.arange(Q_BLOCK, dtype=jnp.int32)
        logits = jnp.einsum('bhmqd,bhmkd->bhmqk', qblk, k)
        bias = table[t5_bucket(q_pos, k_pos)].transpose(2, 0, 1)
        logits = logits + bias[None, :, None]
        mask = k_pos[None, :] <= q_pos[:, None]
        logits = jnp.where(mask, logits, -jnp.inf)
        probs = jax.nn.softmax(logits, axis=-1)
        attn = probs[:, :, 0] - lam * probs[:, :, 1]
        return jnp.einsum('bhqk,bhke->bhqe', attn, v)

    out = lax.map(block, (qb, starts))
    out = out.transpose(1, 2, 0, 3, 4).reshape(B, H, S, dv)
    out = rmsnorm(out, subln_g, eps=GN_EPS) * (1.0 - lambda_init)
    y = out.transpose(0, 2, 1, 3).reshape(B, S, D_INNER)
    gated = jax.nn.silu(g.astype(jnp.float32)) * y
    return gated.astype(w_out.dtype) @ w_out


def setup_inputs(seed: int = 0) -> dict:
    key = jax.random.key(seed)
    ks = jax.random.split(key, 14)
    f32 = jnp.float32
    x = jax.random.normal(ks[0], (BATCH, SEQ, D_MODEL), f32)
    pre_norm_g = 1.0 + 0.02 * jax.random.normal(ks[1], (DEPTH, D_MODEL), f32)
    post_norm_g = 1.0 + 0.02 * jax.random.normal(ks[2], (DEPTH, D_MODEL), f32)
    ret_w_in = jax.random.normal(ks[3], (N_RET_LAYERS, D_MODEL, RET_IN_COLS), f32) * D_MODEL ** -0.5
    ret_w_out = jax.random.normal(ks[4], (N_RET_LAYERS, D_INNER, D_MODEL), f32) * D_INNER ** -0.5
    diff_w_in = jax.random.normal(ks[5], (N_DIFF_LAYERS, D_MODEL, DIFF_IN_COLS), f32) * D_MODEL ** -0.5
    diff_w_out = jax.random.normal(ks[6], (N_DIFF_LAYERS, D_INNER, D_MODEL), f32) * D_INNER ** -0.5
    diff_lambda_q1 = 0.1 * jax.random.normal(ks[7], (N_DIFF_LAYERS, DIFF_HEAD_DIM), f32)
    diff_lambda_k1 = 0.1 * jax.random.normal(ks[8], (N_DIFF_LAYERS, DIFF_HEAD_DIM), f32)
    diff_lambda_q2 = 0.1 * jax.random.normal(ks[9], (N_DIFF_LAYERS, DIFF_HEAD_DIM), f32)
    diff_lambda_k2 = 0.1 * jax.random.normal(ks[10], (N_DIFF_LAYERS, DIFF_HEAD_DIM), f32)
    diff_subln_g = 1.0 + 0.02 * jax.random.normal(ks[11], (N_DIFF_LAYERS, DIFF_V_DIM), f32)
    rel_bias = 0.5 * jax.random.normal(ks[12], (REL_BUCKETS, DIFF_HEADS), f32)
    return {"x": x, "pre_norm_g": pre_norm_g, "post_norm_g": post_norm_g,
            "ret_w_in": ret_w_in, "ret_w_out": ret_w_out,
            "diff_w_in": diff_w_in, "diff_w_out": diff_w_out,
            "diff_lambda_q1": diff_lambda_q1, "diff_lambda_k1": diff_lambda_k1,
            "diff_lambda_q2": diff_lambda_q2, "diff_lambda_k2": diff_lambda_k2,
            "diff_subln_g": diff_subln_g, "rel_bias": rel_bias}


def reference(x, pre_norm_g, post_norm_g, ret_w_in, ret_w_out, diff_w_in, diff_w_out,
              diff_lambda_q1, diff_lambda_k1, diff_lambda_q2, diff_lambda_k2,
              diff_subln_g, rel_bias):
    for i in range(DEPTH):
        h = rmsnorm(x, pre_norm_g[i])
        j = i // N_MIXERS
        if i % N_MIXERS == 0:
            y = retention_mixer(h, ret_w_in[j], ret_w_out[j])
        else:
            lambda_init = 0.8 - 0.6 * math.exp(-0.3 * i)
            y = diff_attn_mixer(h, diff_w_in[j], diff_w_out[j],
                                diff_lambda_q1[j], diff_lambda_k1[j],
                                diff_lambda_q2[j], diff_lambda_k2[j],
                                diff_subln_g[j], rel_bias, lambda_init)
        x = x + rmsnorm(y, post_norm_g[i])
    return x
```

```cpp
#include <hip/hip_runtime.h>
#include <cstdio>
#include <cstdint>
#include <cstring>
#include <cmath>
namespace pg8 {
#define PG8_LAS __attribute__((address_space(3)))
typedef unsigned short bf16_t;
typedef short bf16x8 __attribute__((ext_vector_type(8)));
typedef float f32x4 __attribute__((ext_vector_type(4)));
typedef unsigned u32x4 __attribute__((ext_vector_type(4)));
constexpr int BM = 256, BK = 64, HALF = 128, HTB = HALF * BK * 2  , STAGE_BYTES = 8 * HTB, NXCD = 8, WGM = 8;

__host__ __device__ __forceinline__ int lds_byte(int r, int c) { const int st = (r >> 4) * 2 + (c >> 5), rr = r & 15, cc = c & 31, ob = rr * 64 + cc * 2; return st * 1024 + (ob ^ (((ob >> 9) & 1) << 5)); }
__host__ __device__ __forceinline__ void stage_rc(int b, int& R, int& C) { const int st = b / 1024, sb = b % 1024, swz = sb ^ (((sb >> 9) & 1) << 5); R = (st >> 1) * 16 + swz / 64; C = (st & 1) * 32 + (swz % 64) / 2; }
__host__ __device__ __forceinline__ int perm32(int rho) { const int n = rho >> 4, i = rho & 15; return 8 * (i >> 2) + 4 * n + (i & 3); }

struct Unit { int pm, pn; };
struct Gemm { const bf16_t* A; const bf16_t* Bt; int M, N, K; };

struct StaticOrder {
    int nM, nN, nwg, G, c;
    __host__ __device__ void init(int M, int N, int G_, int c_) { nM = M / BM; nN = N / BM; nwg = nM * nN; G = G_; c = c_; }
    __host__ __device__ bool next(int i, Unit& u) const {
        const long L = (long)i * G + c; if (L >= nwg) return false;
        int wgid = (int)L; { const int q = nwg / NXCD, r = nwg % NXCD, xcd = wgid % NXCD, off = wgid / NXCD; wgid = (xcd < r ? xcd * (q + 1) : r * (q + 1) + (xcd - r) * q) + off; }
        const int nig = WGM * nN, gid = wgid / nig, fm = gid * WGM, gsz = (nM - fm) < WGM ? (nM - fm) : WGM;
        u.pm = fm + ((wgid % nig) % gsz); u.pn = (wgid % nig) / gsz; return true;
    }
    __device__ __forceinline__ void a_ready(const Unit&) const {}
    __device__ __forceinline__ void done(const Unit&) const {}
};


__device__ __forceinline__ unsigned cvt_pk_bf16(float lo, float hi) { unsigned r; asm volatile("v_cvt_pk_bf16_f32 %0, %1, %2" : "=v"(r) : "v"(lo), "v"(hi)); return r; }
__device__ __forceinline__ float silu_f(float x) { return x * __builtin_amdgcn_rcpf(1.0f + __builtin_amdgcn_exp2f(-1.4426950408889634f * x)); }
__device__ __forceinline__ float bf_lo(unsigned w) { return __uint_as_float(w << 16); }
__device__ __forceinline__ float bf_hi(unsigned w) { return __uint_as_float(w & 0xffff0000u); }

struct EpiBf16S {
    static constexpr bool PERM = true, AFTER_DRAIN = false;
    bf16_t* O; size_t split_stride; int ldc; int split_cols; float scale0; int pad;
    __device__ __forceinline__ void operator()(const f32x4 (&acc)[2][2][4][2], const Unit& u, int wr, int wc, int fr, int fq) const {
        const int row0 = u.pm * BM + wr * 64 + fr; int colt = u.pn * BM; bf16_t* base = O;
        float sc = 1.f; if (split_cols) { const int t = colt / split_cols; base += (size_t)t * split_stride; colt -= t * split_cols; if (t == 0) sc = scale0; }
        const int col0 = colt + wc * 32 + 8 * fq;
#pragma unroll
        for (int ai = 0; ai < 2; ++ai)
#pragma unroll
            for (int m = 0; m < 4; ++m) { bf16_t* rowp = base + (size_t)(row0 + ai * HALF + m * 16) * ldc + col0;
#pragma unroll
                for (int bj = 0; bj < 2; ++bj) { f32x4 v0 = acc[ai][bj][m][0] * sc, v1 = acc[ai][bj][m][1] * sc;
                    u32x4 w; w.x = cvt_pk_bf16(v0[0], v0[1]); w.y = cvt_pk_bf16(v0[2], v0[3]); w.z = cvt_pk_bf16(v1[0], v1[1]); w.w = cvt_pk_bf16(v1[2], v1[3]);
                    *(u32x4*)(rowp + bj * HALF) = w; } }
    }
};

struct EpiF32 {
    static constexpr bool PERM = false, AFTER_DRAIN = false;
    float* O; int ldc; int pad;
    __device__ __forceinline__ void operator()(const f32x4 (&acc)[2][2][4][2], const Unit& u, int wr, int wc, int fr, int fq) const {
        const int row0 = u.pm * BM + wr * 64 + fr; const int col0 = u.pn * BM + wc * 32 + 4 * fq;
#pragma unroll
        for (int ai = 0; ai < 2; ++ai)
#pragma unroll
            for (int m = 0; m < 4; ++m) { float* rowp = O + (size_t)(row0 + ai * HALF + m * 16) * ldc + col0;
#pragma unroll
                for (int bj = 0; bj < 2; ++bj)
#pragma unroll
                    for (int n = 0; n < 2; ++n) *(f32x4*)(rowp + bj * HALF + n * 16) = acc[ai][bj][m][n]; }
    }
};

template <bool FOLD> struct EpiRetIn {
    static constexpr bool PERM = true, AFTER_DRAIN = false;
    bf16_t *Q, *K, *V, *G;
    __device__ __forceinline__ void operator()(const f32x4 (&acc)[2][2][4][2], const Unit& u, int wr, int wc, int fr, int fq) const {
        const int row0 = u.pm * BM + wr * 64 + fr; const int c8 = wc * 32 + 8 * fq; const int pn = u.pn;
        if (pn < 8) {
            const bool isq = pn < 4; const int head = pn & 3;
            bf16_t* base = (isq ? Q : K) + head * 256 + c8;
            float wv[8];
#pragma unroll
            for (int j = 0; j < 8; ++j) wv[j] = __builtin_amdgcn_exp2f(-(float)(c8 + j) * (13.287712379549449f / 128.0f)) * 0.15915494309189535f;
            const float lg2 = __log2f(1.0f - __builtin_amdgcn_exp2f(-5.0f - (float)head));
#pragma unroll
            for (int ai = 0; ai < 2; ++ai)
#pragma unroll
                for (int m = 0; m < 4; ++m) {
                    const int row = row0 + ai * HALF + m * 16; const int t = row & 8191; const float pos = (float)t;
                    float sc = isq ? 1.0f : 0.0625f;
                    if (FOLD) { const float e = (float)((t & 63) + 1) * lg2; sc *= __builtin_amdgcn_exp2f(isq ? e : -e); }
                    float o1[8], o2[8];
#pragma unroll
                    for (int n = 0; n < 2; ++n)
#pragma unroll
                        for (int i = 0; i < 4; ++i) { const int j = 4 * n + i;
                            float rev = pos * wv[j]; rev = __builtin_amdgcn_fractf(rev);
                            const float cs = __builtin_amdgcn_cosf(rev), sn = __builtin_amdgcn_sinf(rev);
                            const float x1 = acc[ai][0][m][n][i], x2 = acc[ai][1][m][n][i];
                            o1[j] = (x1 * cs - x2 * sn) * sc; o2[j] = (x1 * sn + x2 * cs) * sc; }
                    u32x4 w1, w2;
                    w1.x = cvt_pk_bf16(o1[0], o1[1]); w1.y = cvt_pk_bf16(o1[2], o1[3]); w1.z = cvt_pk_bf16(o1[4], o1[5]); w1.w = cvt_pk_bf16(o1[6], o1[7]);
                    w2.x = cvt_pk_bf16(o2[0], o2[1]); w2.y = cvt_pk_bf16(o2[2], o2[3]); w2.z = cvt_pk_bf16(o2[4], o2[5]); w2.w = cvt_pk_bf16(o2[6], o2[7]);
                    bf16_t* rp = base + (size_t)row * 1024;
                    *(u32x4*)(rp) = w1; *(u32x4*)(rp + HALF) = w2;
                }
        } else {
            const bool isv = pn < 16; const int colt = (isv ? pn - 8 : pn - 16) * BM;
            bf16_t* base = (isv ? V : G) + colt + c8;
#pragma unroll
            for (int ai = 0; ai < 2; ++ai)
#pragma unroll
                for (int m = 0; m < 4; ++m) { bf16_t* rowp = base + (size_t)(row0 + ai * HALF + m * 16) * 2048;
#pragma unroll
                    for (int bj = 0; bj < 2; ++bj) { f32x4 v0 = acc[ai][bj][m][0], v1 = acc[ai][bj][m][1];
                        if (!isv) {
#pragma unroll
                            for (int i = 0; i < 4; ++i) { v0[i] = silu_f(v0[i]); v1[i] = silu_f(v1[i]); } }
                        u32x4 w; w.x = cvt_pk_bf16(v0[0], v0[1]); w.y = cvt_pk_bf16(v0[2], v0[3]); w.z = cvt_pk_bf16(v1[0], v1[1]); w.w = cvt_pk_bf16(v1[2], v1[3]);
                        *(u32x4*)(rowp + bj * HALF) = w; } }
        }
    }
};

struct EpiGate {
    static constexpr bool PERM = true, AFTER_DRAIN = false;
    bf16_t* O; int ldc; int pad;
    __device__ __forceinline__ void operator()(const f32x4 (&acc)[2][2][4][2], const Unit& u, int wr, int wc, int fr, int fq) const {
        const int row0 = u.pm * BM + wr * 64 + fr; const int col0 = u.pn * BM + wc * 32 + 8 * fq;
#pragma unroll
        for (int ai = 0; ai < 2; ++ai)
#pragma unroll
            for (int m = 0; m < 4; ++m) { bf16_t* rowp = O + (size_t)(row0 + ai * HALF + m * 16) * ldc + col0;
#pragma unroll
                for (int bj = 0; bj < 2; ++bj) { const f32x4 v0 = acc[ai][bj][m][0], v1 = acc[ai][bj][m][1];
                    const u32x4 ov = *(const u32x4*)(rowp + bj * HALF);
                    u32x4 w;
                    w.x = cvt_pk_bf16(silu_f(v0[0]) * bf_lo(ov.x), silu_f(v0[1]) * bf_hi(ov.x));
                    w.y = cvt_pk_bf16(silu_f(v0[2]) * bf_lo(ov.y), silu_f(v0[3]) * bf_hi(ov.y));
                    w.z = cvt_pk_bf16(silu_f(v1[0]) * bf_lo(ov.z), silu_f(v1[1]) * bf_hi(ov.z));
                    w.w = cvt_pk_bf16(silu_f(v1[2]) * bf_lo(ov.w), silu_f(v1[3]) * bf_hi(ov.w));
                    *(u32x4*)(rowp + bj * HALF) = w; } }
    }
};
template <class Epi, class Sched, bool ALIGN_EPI = false, bool SP2 = false>
__device__ __forceinline__ void gemm_phase(PG8_LAS unsigned char* lds, const Gemm g, const Sched& S, const Epi& E) {
    const int tid = threadIdx.x, wid = __builtin_amdgcn_readfirstlane(tid >> 6), lane = tid & 63, wr = wid >> 2, wc = wid & 3, fr = lane & 15, fq = lane >> 4;
    const int K = g.K, nt = K / BK;
    unsigned voffA[2], voffB[2];
#pragma unroll
    for (int i = 0; i < 2; ++i) { int R, C; stage_rc(tid * 16 + i * 8192, R, C); const int Rb = Epi::PERM ? ((R & ~31) + perm32(R & 31)) : R;
        voffA[i] = (unsigned)(R * K + C) * 2u; voffB[i] = (unsigned)(Rb * K + C) * 2u; }
    const size_t kstep = (size_t)(BK * 2);
    const size_t hstep = (size_t)HALF * K * 2;
    const size_t tstep = 2 * hstep;
    const unsigned ldsw = (unsigned)wid * 1024u;
    const int aoff = lds_byte(wr * 64 + fr, fq * 8), boff = lds_byte(wc * 32 + fr, fq * 8);
#define PG8_SA(b, h) (((b) * 2 + (h)) * HTB)
#define PG8_SB(b, h) ((4 + (b) * 2 + (h)) * HTB)
#define PG8_STAGE(bufoff, gbase, voff) do { _Pragma("unroll") for (int _i = 0; _i < 2; ++_i) \
        __builtin_amdgcn_global_load_lds((const unsigned*)((const char*)(gbase) + (voff)[_i]), (PG8_LAS unsigned*)(lds + (bufoff) + ldsw + _i * 8192), 16, 0, 0); } while (0)
#define PG8_LDA(dst, b, h) do { _Pragma("unroll") for (int m = 0; m < 4; ++m) _Pragma("unroll") for (int k = 0; k < 2; ++k) dst[m][k] = *(const PG8_LAS bf16x8*)(lds + PG8_SA(b, h) + aoff + m * 2048 + k * 1024); } while (0)
#define PG8_LDB(dst, b, h) do { _Pragma("unroll") for (int n = 0; n < 2; ++n) _Pragma("unroll") for (int k = 0; k < 2; ++k) dst[n][k] = *(const PG8_LAS bf16x8*)(lds + PG8_SB(b, h) + boff + n * 2048 + k * 1024); } while (0)
#define PG8_MMA(ai, bj, At, Bt) do { __builtin_amdgcn_s_setprio(1); _Pragma("unroll") for (int m = 0; m < 4; ++m) _Pragma("unroll") for (int n = 0; n < 2; ++n) _Pragma("unroll") for (int k = 0; k < 2; ++k) \
        acc[ai][bj][m][n] = __builtin_amdgcn_mfma_f32_16x16x32_bf16(Bt[n][k], At[m][k], acc[ai][bj][m][n], 0, 0, 0); __builtin_amdgcn_s_setprio(0); } while (0)
#define PG8_WAIT_V(n) asm volatile("s_waitcnt vmcnt(" #n ")" ::: "memory")
#define PG8_WAIT_L(n) asm volatile("s_waitcnt lgkmcnt(" #n ")" ::: "memory")
#define PG8_BAR __builtin_amdgcn_s_barrier()
#define PG8_SCHED __builtin_amdgcn_sched_barrier(0)
    Unit cur, nxt; int ui = 0;
    if (!S.next(0, cur)) return;
    f32x4 acc[2][2][4][2];
#pragma unroll
    for (int a = 0; a < 2; ++a)
#pragma unroll
        for (int b = 0; b < 2; ++b)
#pragma unroll
            for (int m = 0; m < 4; ++m)
#pragma unroll
                for (int n = 0; n < 2; ++n) acc[a][b][m][n] = (f32x4){0.f, 0.f, 0.f, 0.f};
    bf16x8 At[4][2], B0[2][2], B1[2][2];
    const char* cA = (const char*)g.A + (size_t)cur.pm * tstep; const char* cB = (const char*)g.Bt + (size_t)cur.pn * tstep;
    S.a_ready(cur);
    if constexpr (SP2) {
        PG8_STAGE(PG8_SB(0, 0), cB, voffB); PG8_STAGE(PG8_SB(0, 1), cB + hstep, voffB); PG8_STAGE(PG8_SA(0, 0), cA, voffA); PG8_STAGE(PG8_SA(0, 1), cA + hstep, voffA);
        if (wr == 1) PG8_BAR;
        PG8_WAIT_V(2); PG8_BAR;
        PG8_STAGE(PG8_SB(1, 0), cB + kstep, voffB); PG8_STAGE(PG8_SA(1, 0), cA + kstep, voffA); PG8_STAGE(PG8_SB(1, 1), cB + hstep + kstep, voffB);
        PG8_WAIT_V(6); PG8_BAR;
    } else {
        PG8_STAGE(PG8_SB(0, 0), cB, voffB); PG8_STAGE(PG8_SA(0, 0), cA, voffA); PG8_STAGE(PG8_SB(0, 1), cB + hstep, voffB); PG8_STAGE(PG8_SA(0, 1), cA + hstep, voffA);
        if (wr == 1) PG8_BAR;
        PG8_WAIT_V(4); PG8_BAR;
        PG8_STAGE(PG8_SB(1, 0), cB + kstep, voffB); PG8_STAGE(PG8_SA(1, 0), cA + kstep, voffA); PG8_STAGE(PG8_SB(1, 1), cB + hstep + kstep, voffB);
        PG8_WAIT_V(6); PG8_BAR;
    }
    for (;;) {
        const bool has_next = S.next(ui + 1, nxt);
        const char* nA = has_next ? (const char*)g.A + (size_t)nxt.pm * tstep : cA; const char* nB = has_next ? (const char*)g.Bt + (size_t)nxt.pn * tstep : cB;
        for (int t = 0; t < nt; t += 2) {
            const bool last = (t == nt - 2);
            const char* a1 = cA + (size_t)(t + 1) * kstep;
            const char* a2 = last ? nA : cA + (size_t)(t + 2) * kstep; const char* b2 = last ? nB : cB + (size_t)(t + 2) * kstep;
            const char* a3 = a2 + kstep; const char* b3 = b2 + kstep;
            if (last && has_next) S.a_ready(nxt);
            if constexpr (SP2) {
            PG8_LDB(B0, 0, 0); PG8_LDB(B1, 0, 1); PG8_SCHED; PG8_LDA(At, 0, 0); PG8_STAGE(PG8_SA(1, 1), a1 + hstep, voffA);
            PG8_WAIT_V(8); PG8_WAIT_L(0); PG8_BAR; PG8_MMA(0, 0, At, B0); PG8_MMA(0, 1, At, B1); PG8_BAR; PG8_SCHED;
            PG8_LDA(At, 0, 1); PG8_STAGE(PG8_SB(0, 0), b2, voffB); PG8_STAGE(PG8_SB(0, 1), b2 + hstep, voffB); PG8_STAGE(PG8_SA(0, 0), a2, voffA);
            PG8_WAIT_V(8); PG8_WAIT_L(0); PG8_BAR; PG8_MMA(1, 0, At, B0); PG8_MMA(1, 1, At, B1); PG8_BAR; PG8_SCHED;
            PG8_LDB(B0, 1, 0); PG8_LDB(B1, 1, 1); PG8_SCHED; PG8_LDA(At, 1, 0); PG8_STAGE(PG8_SA(0, 1), a2 + hstep, voffA);
            PG8_WAIT_V(8); PG8_WAIT_L(0); PG8_BAR; PG8_MMA(0, 0, At, B0); PG8_MMA(0, 1, At, B1); PG8_BAR; PG8_SCHED;
            PG8_LDA(At, 1, 1); PG8_STAGE(PG8_SB(1, 0), b3, voffB); PG8_STAGE(PG8_SB(1, 1), b3 + hstep, voffB); PG8_STAGE(PG8_SA(1, 0), a3, voffA);
            PG8_WAIT_V(8); PG8_WAIT_L(0); PG8_BAR; PG8_MMA(1, 0, At, B0); PG8_MMA(1, 1, At, B1); PG8_BAR; PG8_SCHED;
            } else {
            PG8_LDB(B0, 0, 0); PG8_SCHED; PG8_LDA(At, 0, 0); PG8_STAGE(PG8_SA(1, 1), a1 + hstep, voffA);
            PG8_WAIT_L(8); PG8_BAR; PG8_WAIT_L(0); PG8_MMA(0, 0, At, B0); PG8_BAR; PG8_SCHED;
            PG8_LDB(B1, 0, 1); PG8_STAGE(PG8_SB(0, 0), b2, voffB);
            PG8_BAR; PG8_WAIT_L(0); PG8_MMA(0, 1, At, B1); PG8_BAR;
            PG8_LDA(At, 0, 1); PG8_STAGE(PG8_SA(0, 0), a2, voffA);
            PG8_BAR; PG8_WAIT_L(0); PG8_MMA(1, 0, At, B0); PG8_BAR; PG8_SCHED;
            PG8_STAGE(PG8_SB(0, 1), b2 + hstep, voffB);
            PG8_WAIT_V(6); PG8_BAR; PG8_MMA(1, 1, At, B1); PG8_BAR;
            PG8_LDB(B0, 1, 0); PG8_SCHED; PG8_LDA(At, 1, 0); PG8_STAGE(PG8_SA(0, 1), a2 + hstep, voffA);
            PG8_WAIT_L(8); PG8_BAR; PG8_WAIT_L(0); PG8_MMA(0, 0, At, B0); PG8_BAR; PG8_SCHED;
            PG8_LDB(B1, 1, 1); PG8_STAGE(PG8_SB(1, 0), b3, voffB);
            PG8_BAR; PG8_WAIT_L(0); PG8_MMA(0, 1, At, B1); PG8_BAR;
            PG8_LDA(At, 1, 1); PG8_STAGE(PG8_SA(1, 0), a3, voffA);
            PG8_BAR; PG8_WAIT_L(0); PG8_MMA(1, 0, At, B0); PG8_BAR; PG8_SCHED;
            PG8_STAGE(PG8_SB(1, 1), b3 + hstep, voffB);
            PG8_WAIT_V(6); PG8_BAR; PG8_MMA(1, 1, At, B1); PG8_BAR;
            }
        }
        if constexpr (ALIGN_EPI) { if (wr == 0) PG8_BAR; }
        if constexpr (!Epi::AFTER_DRAIN) { E(acc, cur, wr, wc, fr, fq); S.done(cur); }
        if (!has_next) break;
#pragma unroll
        for (int a = 0; a < 2; ++a)
#pragma unroll
            for (int b = 0; b < 2; ++b)
#pragma unroll
                for (int m = 0; m < 4; ++m)
#pragma unroll
                    for (int n = 0; n < 2; ++n) acc[a][b][m][n] = (f32x4){0.f, 0.f, 0.f, 0.f};
        cur = nxt; cA = nA; cB = nB; ++ui;
        if constexpr (ALIGN_EPI) { if (wr == 1) PG8_BAR; }
    }
    PG8_WAIT_V(0);
    if constexpr (!ALIGN_EPI) { if (wr == 0) PG8_BAR; }
    PG8_BAR;
    if constexpr (Epi::AFTER_DRAIN) { E.fused(acc, cur, wr, wc, fr, fq, lds, wid, lane); S.done(cur); }
#undef PG8_SA
#undef PG8_SB
#undef PG8_STAGE
#undef PG8_LDA
#undef PG8_LDB
#undef PG8_MMA
#undef PG8_WAIT_V
#undef PG8_WAIT_L
#undef PG8_BAR
#undef PG8_SCHED
}
}

#define PG8_SP2 true
#define PG8_ALIGN true

constexpr int BATCH = 2, SEQ = 8192, DM = 1024, DI = 2048, MROWS = BATCH * SEQ;
constexpr int RH = 4, RDK = 256, RDV = 512, RCH = 128;
constexpr int RET_COLS = 6144;
constexpr int AH = 16, AD = 64, ADV = 128;
constexpr int DIFF_QKV_COLS = 6144, DIFF_COLS = 8192;
constexpr float RMS_EPS = 1e-6f, GN_EPS = 1e-5f;
constexpr float LOG2E = 1.4426950408889634f;
constexpr float LAMBDA_INIT = 0.35550906759096926f;
constexpr float QSCALE2 = 0.125f * LOG2E;

constexpr size_t MiB = 1u << 20;
constexpr size_t WS_CTL = 0;
constexpr size_t WS_W0IN = 4 * MiB;
constexpr size_t WS_W0OUT = 16 * MiB;
constexpr size_t WS_XN = 20 * MiB;
constexpr size_t WS_A = 52 * MiB;
constexpr size_t WS_Q0 = 52 * MiB, WS_K0 = 84 * MiB, WS_V0 = 116 * MiB, WS_G0 = 180 * MiB;
constexpr size_t WS_Q1 = 52 * MiB, WS_K1 = 116 * MiB, WS_V1 = 180 * MiB;
constexpr size_t WS_YF_L0 = 52 * MiB;
constexpr size_t WS_YF_L1 = 116 * MiB;
constexpr size_t WS_W1G = 244 * MiB;
constexpr size_t WS_W1OUT = 248 * MiB;
constexpr size_t WS_TMP = 244 * MiB;

typedef unsigned short bf16;
typedef unsigned v4u __attribute__((ext_vector_type(4)));
typedef float f32x4 __attribute__((ext_vector_type(4)));

struct Params { const float* in[13]; float* out; unsigned char* ws; int a; int b; };

__device__ __forceinline__ unsigned f2bf(float f) { unsigned u = __builtin_bit_cast(unsigned, f); return (u + 0x7fffu + ((u >> 16) & 1u)) >> 16; }
__device__ __forceinline__ unsigned pk2(float lo, float hi) { return f2bf(lo) | (f2bf(hi) << 16); }
__device__ __forceinline__ float bf2f(bf16 h) { return __uint_as_float((unsigned)h << 16); }
__device__ __forceinline__ float wave_sum(float v) {
#pragma unroll
    for (int o = 1; o < 64; o <<= 1) v += __shfl_xor(v, o);
    return v;
}

__device__ __forceinline__ void transpose_item(const float* W, int K, int N, bf16* WT, int n_lo, float* scr, int item, int lane) {
    const int nblk = N / 32, kb = item / nblk, nb = item % nblk, k0 = 64 * kb, n0 = 32 * nb;
#pragma unroll 8
    for (int i = 0; i < 32; ++i) { const int kk = 2 * i + (lane >> 5); scr[kk * 33 + (lane & 31)] = W[(size_t)(k0 + kk) * N + n0 + (lane & 31)]; }
    __builtin_amdgcn_s_waitcnt(0xc07f); asm volatile("" ::: "memory");
    const int c = lane & 7;
#pragma unroll
    for (int j = 0; j < 4; ++j) { const int n = (lane >> 3) + 8 * j; const float* s = scr + (8 * c) * 33 + n;
        v4u o; o.x = pk2(s[0 * 33], s[1 * 33]); o.y = pk2(s[2 * 33], s[3 * 33]); o.z = pk2(s[4 * 33], s[5 * 33]); o.w = pk2(s[6 * 33], s[7 * 33]);
        const int ng = n0 + n - n_lo;
        if (ng >= 0) *(v4u*)(WT + (size_t)ng * K + k0 + 8 * c) = o; }
    __builtin_amdgcn_s_waitcnt(0xc07f); asm volatile("" ::: "memory");
}
__global__ void __launch_bounds__(256) transpose_kernel(const float* W, bf16* WT, int K, int N, int n_lo, int n_hi) {
    __shared__ float scr_all[4][64 * 33];
    const int lane = threadIdx.x & 63, wave = threadIdx.x >> 6;
    const int gw = blockIdx.x * 4 + wave, NGW = gridDim.x * 4;
    const int nblk = N / 32, nitems = (K / 64) * nblk;
    for (int it = gw; it < nitems; it += NGW) {
        const int nb = it % nblk; if (nb * 32 < n_lo || nb * 32 >= n_hi) continue;
        transpose_item(W, K, N, WT, n_lo, scr_all[wave], it, lane);
    }
}

__global__ void __launch_bounds__(256) norm_kernel(const float* y, const float* base, const float* gpost, const float* gpre, float* out, bf16* xn, int mode, int pad) {
    const int lane = threadIdx.x & 63, wave = threadIdx.x >> 6;
    const int gw = blockIdx.x * 4 + wave, NGW = gridDim.x * 4;
    for (int m = gw; m < MROWS; m += NGW) {
        const f32x4* yr = (const f32x4*)(y + (size_t)m * DM) + lane;
        f32x4 v[4]; float s = 0.f;
#pragma unroll
        for (int j = 0; j < 4; ++j) { v[j] = yr[64 * j]; s += (v[j].x * v[j].x + v[j].y * v[j].y) + (v[j].z * v[j].z + v[j].w * v[j].w); }
        const float rstd = 1.0f / sqrtf(wave_sum(s) * (1.0f / DM) + RMS_EPS);
        if (mode == 0) {
            unsigned long long* o8 = (unsigned long long*)(xn + (size_t)m * DM) + lane;
#pragma unroll
            for (int j = 0; j < 4; ++j) { const f32x4 g = ((const f32x4*)gpre)[64 * j + lane];
                o8[64 * j] = (unsigned long long)pk2(v[j].x * rstd * g.x, v[j].y * rstd * g.y) | ((unsigned long long)pk2(v[j].z * rstd * g.z, v[j].w * rstd * g.w) << 32); }
        } else {
            const f32x4* br = (const f32x4*)(base + (size_t)m * DM) + lane; f32x4* orow = (f32x4*)(out + (size_t)m * DM) + lane;
            float s2 = 0.f;
#pragma unroll
            for (int j = 0; j < 4; ++j) { const f32x4 g = ((const f32x4*)gpost)[64 * j + lane]; const f32x4 b = br[64 * j];
                v[j] = b + v[j] * rstd * g; orow[64 * j] = v[j];
                s2 += (v[j].x * v[j].x + v[j].y * v[j].y) + (v[j].z * v[j].z + v[j].w * v[j].w); }
            if (mode == 1) {
                const float r2 = 1.0f / sqrtf(wave_sum(s2) * (1.0f / DM) + RMS_EPS);
                unsigned long long* o8 = (unsigned long long*)(xn + (size_t)m * DM) + lane;
#pragma unroll
                for (int j = 0; j < 4; ++j) { const f32x4 g = ((const f32x4*)gpre)[64 * j + lane];
                    o8[64 * j] = (unsigned long long)pk2(v[j].x * r2 * g.x, v[j].y * r2 * g.y) | ((unsigned long long)pk2(v[j].z * r2 * g.z, v[j].w * r2 * g.w) << 32); }
            }
        }
    }
}

template <class Epi> struct GemmArgs { const bf16* A; const bf16* Bt; int M, N, K, pad; Epi e; };
template <class Epi> __global__ void __launch_bounds__(512, 2) gemm_kernel(GemmArgs<Epi> a) {
    extern __shared__ __attribute__((aligned(16))) unsigned char lds[];
    pg8::Gemm g{a.A, a.Bt, a.M, a.N, a.K};
    pg8::StaticOrder S; S.init(a.M, a.N, gridDim.x, blockIdx.x);
    pg8::gemm_phase<Epi, pg8::StaticOrder, PG8_ALIGN, PG8_SP2>((PG8_LAS unsigned char*)lds, g, S, a.e);
}
template <class Epi> static void launch_gemm(const bf16* A, const bf16* Bt, int M, int N, int K, const Epi& e, hipStream_t stream) {
    GemmArgs<Epi> a; memset(&a, 0, sizeof(a)); a.A = A; a.Bt = Bt; a.M = M; a.N = N; a.K = K; a.e = e;
    gemm_kernel<Epi><<<256, 512, 131072, stream>>>(a);
}

__device__ __forceinline__ float ret_lg(int h) { return log1pf(-exp2f(-5.0f - (float)h)); }
__global__ void __launch_bounds__(256) nret_scores(const bf16* Q, const bf16* K, float* S, int n, int pad) {
    const int idx = blockIdx.x * 256 + threadIdx.x;
    const int j = idx & 127, i = (idx >> 7) & 127, bh = idx >> 14, b = bh >> 2, h = bh & 3;
    const bf16* q = Q + (size_t)(b * SEQ + n * RCH + i) * 1024 + h * RDK;
    const bf16* k = K + (size_t)(b * SEQ + n * RCH + j) * 1024 + h * RDK;
    float s = 0.f;
    for (int d = 0; d < RDK; ++d) s += bf2f(q[d]) * bf2f(k[d]);
    S[idx] = s;
}
__global__ void __launch_bounds__(256) nret_out(const bf16* Q, const bf16* V, const float* S, const float* R, bf16* RET, int n, int pad) {
    const int idx = blockIdx.x * 256 + threadIdx.x;
    const int e = idx & 511, i = (idx >> 9) & 127, bh = idx >> 16, b = bh >> 2, h = bh & 3;
    const float lg = ret_lg(h);
    const float* Srow = S + ((size_t)bh * 128 + i) * 128;
    float acc = 0.f;
    for (int j = 0; j <= i; ++j) acc += expf(lg * (float)(i - j)) * Srow[j] * bf2f(V[(size_t)(b * SEQ + n * RCH + j) * 2048 + h * RDV + e]);
    const bf16* q = Q + (size_t)(b * SEQ + n * RCH + i) * 1024 + h * RDK;
    const float* Rb = R + (size_t)bh * RDK * RDV + e;
    float cr = 0.f;
    if (n > 0) for (int d = 0; d < RDK; ++d) cr += bf2f(q[d]) * Rb[(size_t)d * RDV];
    acc += expf(lg * (float)(i + 1)) * cr;
    RET[(size_t)(b * SEQ + n * RCH + i) * 2048 + h * RDV + e] = (bf16)f2bf(acc);
}
__global__ void __launch_bounds__(256) nret_state(const bf16* K, const bf16* V, float* R, int n, int pad) {
    const int idx = blockIdx.x * 256 + threadIdx.x;
    const int e = idx & 511, d = (idx >> 9) & 255, bh = idx >> 17, b = bh >> 2, h = bh & 3;
    const float lg = ret_lg(h);
    float acc = 0.f;
    for (int j = 0; j < RCH; ++j) acc += expf(lg * (float)(RCH - 1 - j)) * bf2f(K[(size_t)(b * SEQ + n * RCH + j) * 1024 + h * RDK + d]) * bf2f(V[(size_t)(b * SEQ + n * RCH + j) * 2048 + h * RDV + e]);
    R[idx] = (n == 0 ? 0.f : expf(lg * (float)RCH) * R[idx]) + acc;
}
__global__ void __launch_bounds__(256) gn_gate_kernel(const bf16* RET, bf16* G) {
    const int lane = threadIdx.x & 63, wave = threadIdx.x >> 6;
    const int gw = blockIdx.x * 4 + wave, NGW = gridDim.x * 4;
    for (int it = gw; it < MROWS * RH; it += NGW) {
        const size_t off = (size_t)it * RDV + lane * 8;
        const v4u rv = *(const v4u*)(RET + off); const v4u gv = *(const v4u*)(G + off);
        float x[8] = {pg8::bf_lo(rv.x), pg8::bf_hi(rv.x), pg8::bf_lo(rv.y), pg8::bf_hi(rv.y), pg8::bf_lo(rv.z), pg8::bf_hi(rv.z), pg8::bf_lo(rv.w), pg8::bf_hi(rv.w)};
        float g[8] = {pg8::bf_lo(gv.x), pg8::bf_hi(gv.x), pg8::bf_lo(gv.y), pg8::bf_hi(gv.y), pg8::bf_lo(gv.z), pg8::bf_hi(gv.z), pg8::bf_lo(gv.w), pg8::bf_hi(gv.w)};
        float s = 0.f;
#pragma unroll
        for (int j = 0; j < 8; ++j) s += x[j];
        const float mu = wave_sum(s) * (1.0f / RDV);
        float q = 0.f;
#pragma unroll
        for (int j = 0; j < 8; ++j) { x[j] -= mu; q += x[j] * x[j]; }
        const float rstd = 1.0f / sqrtf(wave_sum(q) * (1.0f / RDV) + GN_EPS);
        v4u o; o.x = pk2(x[0] * rstd * g[0], x[1] * rstd * g[1]); o.y = pk2(x[2] * rstd * g[2], x[3] * rstd * g[3]);
        o.z = pk2(x[4] * rstd * g[4], x[5] * rstd * g[5]); o.w = pk2(x[6] * rstd * g[6], x[7] * rstd * g[7]);
        *(v4u*)(G + off) = o;
    }
}

__device__ __forceinline__ int t5_bucket(int n) {
    if (n < 16) return n;
    int l = 16 + (int)(logf((float)n / 16.0f) / 2.0794415416798357f * 16.0f);
    return l < 31 ? l : 31;
}
__global__ void __launch_bounds__(64) nattn_kernel(bf16* Q, const bf16* K, const bf16* V, const float* lq1, const float* lk1, const float* lq2, const float* lk2,
                                                   const float* subln_g, const float* rel_bias) {
    __shared__ float o1s[128][64];
    __shared__ float btab[128];
    const int lane = threadIdx.x;
    const int blk = blockIdx.x;
    const int qb = blk & 127, bh = blk >> 7, b = bh >> 4, h = bh & 15;
    const int t = qb * 64 + lane;
    btab[lane] = rel_bias[t5_bucket(lane) * 16 + h] * LOG2E; btab[lane + 64] = rel_bias[t5_bucket(lane + 64) * 16 + h] * LOG2E;
    __syncthreads();
    float d1 = 0.f, d2 = 0.f;
    for (int i = 0; i < 64; ++i) { d1 += lq1[i] * lk1[i]; d2 += lq2[i] * lk2[i]; }
    const float lam = expf(d1) - expf(d2) + LAMBDA_INIT;
    const int kmax = qb * 64 + 63;
    float o[128];
    for (int map = 0; map < 2; ++map) {
        float q[64];
        const v4u* qp = (const v4u*)(Q + (size_t)(b * SEQ + t) * 2048 + h * 128 + map * 64);
#pragma unroll
        for (int c = 0; c < 8; ++c) { const v4u w = qp[c]; q[8*c] = pg8::bf_lo(w.x); q[8*c+1] = pg8::bf_hi(w.x); q[8*c+2] = pg8::bf_lo(w.y); q[8*c+3] = pg8::bf_hi(w.y);
            q[8*c+4] = pg8::bf_lo(w.z); q[8*c+5] = pg8::bf_hi(w.z); q[8*c+6] = pg8::bf_lo(w.w); q[8*c+7] = pg8::bf_hi(w.w); }
        float mx = -INFINITY;
        for (int k = 0; k <= kmax; ++k) {
            const v4u* kp = (const v4u*)(K + (size_t)(b * SEQ + k) * 2048 + h * 128 + map * 64);
            float s = 0.f;
#pragma unroll
            for (int c = 0; c < 8; ++c) { const v4u w = kp[c];
                s += q[8*c] * pg8::bf_lo(w.x) + q[8*c+1] * pg8::bf_hi(w.x) + q[8*c+2] * pg8::bf_lo(w.y) + q[8*c+3] * pg8::bf_hi(w.y)
                   + q[8*c+4] * pg8::bf_lo(w.z) + q[8*c+5] * pg8::bf_hi(w.z) + q[8*c+6] * pg8::bf_lo(w.w) + q[8*c+7] * pg8::bf_hi(w.w); }
            const int dist = t - k;
            if (dist >= 0) { s += btab[dist < 127 ? dist : 127]; mx = fmaxf(mx, s); }
        }
#pragma unroll
        for (int e = 0; e < 128; ++e) o[e] = 0.f;
        float l = 0.f;
        for (int k = 0; k <= kmax; ++k) {
            const v4u* kp = (const v4u*)(K + (size_t)(b * SEQ + k) * 2048 + h * 128 + map * 64);
            float s = 0.f;
#pragma unroll
            for (int c = 0; c < 8; ++c) { const v4u w = kp[c];
                s += q[8*c] * pg8::bf_lo(w.x) + q[8*c+1] * pg8::bf_hi(w.x) + q[8*c+2] * pg8::bf_lo(w.y) + q[8*c+3] * pg8::bf_hi(w.y)
                   + q[8*c+4] * pg8::bf_lo(w.z) + q[8*c+5] * pg8::bf_hi(w.z) + q[8*c+6] * pg8::bf_lo(w.w) + q[8*c+7] * pg8::bf_hi(w.w); }
            const int dist = t - k;
            float p = 0.f;
            if (dist >= 0) { s += btab[dist < 127 ? dist : 127]; p = exp2f(s - mx); }
            l += p;
            const v4u* vp = (const v4u*)(V + (size_t)(b * SEQ + k) * 2048 + h * 128);
#pragma unroll
            for (int c = 0; c < 16; ++c) { const v4u w = vp[c];
                o[8*c] += p * pg8::bf_lo(w.x); o[8*c+1] += p * pg8::bf_hi(w.x); o[8*c+2] += p * pg8::bf_lo(w.y); o[8*c+3] += p * pg8::bf_hi(w.y);
                o[8*c+4] += p * pg8::bf_lo(w.z); o[8*c+5] += p * pg8::bf_hi(w.z); o[8*c+6] += p * pg8::bf_lo(w.w); o[8*c+7] += p * pg8::bf_hi(w.w); }
        }
        const float linv = 1.0f / l;
        if (map == 0) {
#pragma unroll
            for (int e = 0; e < 128; ++e) o1s[e][lane] = o[e] * linv;
        } else {
            float ss = 0.f;
#pragma unroll
            for (int e = 0; e < 128; ++e) { o[e] = o1s[e][lane] - lam * (o[e] * linv); ss += o[e] * o[e]; }
            const float r = 1.0f / sqrtf(ss * (1.0f / 128.0f) + GN_EPS) * (1.0f - LAMBDA_INIT);
            bf16* op = Q + (size_t)(b * SEQ + t) * 2048 + h * 128;
#pragma unroll
            for (int e = 0; e < 128; e += 2) *(unsigned*)(op + e) = pk2(o[e] * r * subln_g[e], o[e + 1] * r * subln_g[e + 1]);
        }
    }
}

extern "C" void kernel_launch(void* const* d_in, const int* in_sizes, int n_in, void* d_out, int out_size, void* d_ws, size_t ws_size, hipStream_t stream) {
    const float* x = (const float*)d_in[0]; const float* pre_g = (const float*)d_in[1]; const float* post_g = (const float*)d_in[2];
    const float* ret_w_in = (const float*)d_in[3]; const float* ret_w_out = (const float*)d_in[4];
    const float* diff_w_in = (const float*)d_in[5]; const float* diff_w_out = (const float*)d_in[6];
    const float* lq1 = (const float*)d_in[7]; const float* lk1 = (const float*)d_in[8]; const float* lq2 = (const float*)d_in[9]; const float* lk2 = (const float*)d_in[10];
    const float* subln_g = (const float*)d_in[11]; const float* rel_bias = (const float*)d_in[12];
    float* out = (float*)d_out; unsigned char* ws = (unsigned char*)d_ws;
    bf16* W0in = (bf16*)(ws + WS_W0IN); bf16* W0out = (bf16*)(ws + WS_W0OUT); bf16* XN = (bf16*)(ws + WS_XN);
    bf16* Q0 = (bf16*)(ws + WS_Q0); bf16* K0 = (bf16*)(ws + WS_K0); bf16* V0 = (bf16*)(ws + WS_V0); bf16* G0 = (bf16*)(ws + WS_G0);
    bf16* Q1 = (bf16*)(ws + WS_Q1); bf16* K1 = (bf16*)(ws + WS_K1); bf16* V1 = (bf16*)(ws + WS_V1);
    bf16* W1g = (bf16*)(ws + WS_W1G); bf16* W1out = (bf16*)(ws + WS_W1OUT);
    float* YF0 = (float*)(ws + WS_YF_L0); float* YF1 = (float*)(ws + WS_YF_L1);
    float* Sbuf = (float*)(ws + WS_TMP); float* Rbuf = (float*)(ws + WS_TMP + 1 * MiB);
    bf16* RET = (bf16*)d_out;
    constexpr int LDSB = 131072;
    static bool attr = false;
    if (!attr) {
        hipFuncSetAttribute((const void*)gemm_kernel<pg8::EpiRetIn<false>>, hipFuncAttributeMaxDynamicSharedMemorySize, LDSB);
        hipFuncSetAttribute((const void*)gemm_kernel<pg8::EpiF32>, hipFuncAttributeMaxDynamicSharedMemorySize, LDSB);
        hipFuncSetAttribute((const void*)gemm_kernel<pg8::EpiBf16S>, hipFuncAttributeMaxDynamicSharedMemorySize, LDSB);
        hipFuncSetAttribute((const void*)gemm_kernel<pg8::EpiGate>, hipFuncAttributeMaxDynamicSharedMemorySize, LDSB);
        attr = true;
    }
    transpose_kernel<<<1024, 256, 0, stream>>>(ret_w_in, W0in, DM, RET_COLS, 0, RET_COLS);
    transpose_kernel<<<1024, 256, 0, stream>>>(ret_w_out, W0out, DI, DM, 0, DM);
    norm_kernel<<<1024, 256, 0, stream>>>(x, nullptr, nullptr, pre_g, nullptr, XN, 0, 0);
    { pg8::EpiRetIn<false> e{Q0, K0, V0, G0}; launch_gemm(XN, W0in, MROWS, RET_COLS, DM, e, stream); }
    for (int n = 0; n < SEQ / RCH; ++n) {
        nret_scores<<<8 * 128 * 128 / 256, 256, 0, stream>>>(Q0, K0, Sbuf, n, 0);
        nret_out<<<8 * 128 * 512 / 256, 256, 0, stream>>>(Q0, V0, Sbuf, Rbuf, RET, n, 0);
        nret_state<<<8 * 256 * 512 / 256, 256, 0, stream>>>(K0, V0, Rbuf, n, 0);
    }
    gn_gate_kernel<<<2048, 256, 0, stream>>>(RET, G0);
    { pg8::EpiF32 e{YF0, DM, 0}; launch_gemm(G0, W0out, MROWS, DM, DI, e, stream); }
    norm_kernel<<<1024, 256, 0, stream>>>(YF0, x, post_g, pre_g + DM, out, XN, 1, 0);
    transpose_kernel<<<1024, 256, 0, stream>>>(diff_w_in, W0in, DM, DIFF_COLS, 0, DIFF_QKV_COLS);
    transpose_kernel<<<1024, 256, 0, stream>>>(diff_w_in, W1g, DM, DIFF_COLS, DIFF_QKV_COLS, DIFF_COLS);
    transpose_kernel<<<1024, 256, 0, stream>>>(diff_w_out, W1out, DI, DM, 0, DM);
    { pg8::EpiBf16S e{Q1, (size_t)(WS_K1 - WS_Q1) / 2, DI, DI, QSCALE2, 0}; launch_gemm(XN, W0in, MROWS, DIFF_QKV_COLS, DM, e, stream); }
    nattn_kernel<<<BATCH * AH * (SEQ / 64), 64, 0, stream>>>(Q1, K1, V1, lq1, lk1, lq2, lk2, subln_g, rel_bias);
    { pg8::EpiGate e{Q1, DI, 0}; launch_gemm(XN, W1g, MROWS, DI, DM, e, stream); }
    { pg8::EpiF32 e{YF1, DM, 0}; launch_gemm(Q1, W1out, MROWS, DM, DI, e, stream); }
    norm_kernel<<<1024, 256, 0, stream>>>(YF1, out, post_g + DM, nullptr, out, nullptr, 2, 0);
}
```

```cpp
#include <hip/hip_runtime.h>
#include <cstdio>
#include <cstdint>
#include <cstring>
#include <cmath>
namespace pg8 {
#define PG8_LAS __attribute__((address_space(3)))
typedef unsigned short bf16_t;
typedef short bf16x8 __attribute__((ext_vector_type(8)));
typedef float f32x4 __attribute__((ext_vector_type(4)));
typedef unsigned u32x4 __attribute__((ext_vector_type(4)));
constexpr int BM = 256, BK = 64, HALF = 128, HTB = HALF * BK * 2  , STAGE_BYTES = 8 * HTB, NXCD = 8, WGM = 8;

__host__ __device__ __forceinline__ int lds_byte(int r, int c) { const int st = (r >> 4) * 2 + (c >> 5), rr = r & 15, cc = c & 31, ob = rr * 64 + cc * 2; return st * 1024 + (ob ^ (((ob >> 9) & 1) << 5)); }
__host__ __device__ __forceinline__ void stage_rc(int b, int& R, int& C) { const int st = b / 1024, sb = b % 1024, swz = sb ^ (((sb >> 9) & 1) << 5); R = (st >> 1) * 16 + swz / 64; C = (st & 1) * 32 + (swz % 64) / 2; }
__host__ __device__ __forceinline__ int perm32(int rho) { const int n = rho >> 4, i = rho & 15; return 8 * (i >> 2) + 4 * n + (i & 3); }

struct Unit { int pm, pn; };
struct Gemm { const bf16_t* A; const bf16_t* Bt; int M, N, K; };

struct StaticOrder {
    int nM, nN, nwg, G, c;
    __host__ __device__ void init(int M, int N, int G_, int c_) { nM = M / BM; nN = N / BM; nwg = nM * nN; G = G_; c = c_; }
    __host__ __device__ bool next(int i, Unit& u) const {
        const long L = (long)i * G + c; if (L >= nwg) return false;
        int wgid = (int)L; { const int q = nwg / NXCD, r = nwg % NXCD, xcd = wgid % NXCD, off = wgid / NXCD; wgid = (xcd < r ? xcd * (q + 1) : r * (q + 1) + (xcd - r) * q) + off; }
        const int nig = WGM * nN, gid = wgid / nig, fm = gid * WGM, gsz = (nM - fm) < WGM ? (nM - fm) : WGM;
        u.pm = fm + ((wgid % nig) % gsz); u.pn = (wgid % nig) / gsz; return true;
    }
    __device__ __forceinline__ void a_ready(const Unit&) const {}
    __device__ __forceinline__ void done(const Unit&) const {}
};


__device__ __forceinline__ unsigned cvt_pk_bf16(float lo, float hi) { unsigned r; asm volatile("v_cvt_pk_bf16_f32 %0, %1, %2" : "=v"(r) : "v"(lo), "v"(hi)); return r; }
__device__ __forceinline__ float silu_f(float x) { return x * __builtin_amdgcn_rcpf(1.0f + __builtin_amdgcn_exp2f(-1.4426950408889634f * x)); }
__device__ __forceinline__ float bf_lo(unsigned w) { return __uint_as_float(w << 16); }
__device__ __forceinline__ float bf_hi(unsigned w) { return __uint_as_float(w & 0xffff0000u); }

struct EpiBf16S {
    static constexpr bool PERM = true, AFTER_DRAIN = false;
    bf16_t* O; size_t split_stride; int ldc; int split_cols; float scale0; int pad;
    __device__ __forceinline__ void operator()(const f32x4 (&acc)[2][2][4][2], const Unit& u, int wr, int wc, int fr, int fq) const {
        const int row0 = u.pm * BM + wr * 64 + fr; int colt = u.pn * BM; bf16_t* base = O;
        float sc = 1.f; if (split_cols) { const int t = colt / split_cols; base += (size_t)t * split_stride; colt -= t * split_cols; if (t == 0) sc = scale0; }
        const int col0 = colt + wc * 32 + 8 * fq;
#pragma unroll
        for (int ai = 0; ai < 2; ++ai)
#pragma unroll
            for (int m = 0; m < 4; ++m) { bf16_t* rowp = base + (size_t)(row0 + ai * HALF + m * 16) * ldc + col0;
#pragma unroll
                for (int bj = 0; bj < 2; ++bj) { f32x4 v0 = acc[ai][bj][m][0] * sc, v1 = acc[ai][bj][m][1] * sc;
                    u32x4 w; w.x = cvt_pk_bf16(v0[0], v0[1]); w.y = cvt_pk_bf16(v0[2], v0[3]); w.z = cvt_pk_bf16(v1[0], v1[1]); w.w = cvt_pk_bf16(v1[2], v1[3]);
                    *(u32x4*)(rowp + bj * HALF) = w; } }
    }
};

struct EpiF32 {
    static constexpr bool PERM = false, AFTER_DRAIN = false;
    float* O; int ldc; int pad;
    __device__ __forceinline__ void operator()(const f32x4 (&acc)[2][2][4][2], const Unit& u, int wr, int wc, int fr, int fq) const {
        const int row0 = u.pm * BM + wr * 64 + fr; const int col0 = u.pn * BM + wc * 32 + 4 * fq;
#pragma unroll
        for (int ai = 0; ai < 2; ++ai)
#pragma unroll
            for (int m = 0; m < 4; ++m) { float* rowp = O + (size_t)(row0 + ai * HALF + m * 16) * ldc + col0;
#pragma unroll
                for (int bj = 0; bj < 2; ++bj)
#pragma unroll
                    for (int n = 0; n < 2; ++n) *(f32x4*)(rowp + bj * HALF + n * 16) = acc[ai][bj][m][n]; }
    }
};

template <bool FOLD> struct EpiRetIn {
    static constexpr bool PERM = true, AFTER_DRAIN = false;
    bf16_t *Q, *K, *V, *G;
    __device__ __forceinline__ void operator()(const f32x4 (&acc)[2][2][4][2], const Unit& u, int wr, int wc, int fr, int fq) const {
        const int row0 = u.pm * BM + wr * 64 + fr; const int c8 = wc * 32 + 8 * fq; const int pn = u.pn;
        if (pn < 8) {
            const bool isq = pn < 4; const int head = pn & 3;
            bf16_t* base = (isq ? Q : K) + head * 256 + c8;
            float wv[8];
#pragma unroll
            for (int j = 0; j < 8; ++j) wv[j] = __builtin_amdgcn_exp2f(-(float)(c8 + j) * (13.287712379549449f / 128.0f)) * 0.15915494309189535f;
            const float lg2 = __log2f(1.0f - __builtin_amdgcn_exp2f(-5.0f - (float)head));
#pragma unroll
            for (int ai = 0; ai < 2; ++ai)
#pragma unroll
                for (int m = 0; m < 4; ++m) {
                    const int row = row0 + ai * HALF + m * 16; const int t = row & 8191; const float pos = (float)t;
                    float sc = isq ? 1.0f : 0.0625f;
                    if (FOLD) { const float e = (float)((t & 63) + 1) * lg2; sc *= __builtin_amdgcn_exp2f(isq ? e : -e); }
                    float o1[8], o2[8];
#pragma unroll
                    for (int n = 0; n < 2; ++n)
#pragma unroll
                        for (int i = 0; i < 4; ++i) { const int j = 4 * n + i;
                            float rev = pos * wv[j]; rev = __builtin_amdgcn_fractf(rev);
                            const float cs = __builtin_amdgcn_cosf(rev), sn = __builtin_amdgcn_sinf(rev);
                            const float x1 = acc[ai][0][m][n][i], x2 = acc[ai][1][m][n][i];
                            o1[j] = (x1 * cs - x2 * sn) * sc; o2[j] = (x1 * sn + x2 * cs) * sc; }
                    u32x4 w1, w2;
                    w1.x = cvt_pk_bf16(o1[0], o1[1]); w1.y = cvt_pk_bf16(o1[2], o1[3]); w1.z = cvt_pk_bf16(o1[4], o1[5]); w1.w = cvt_pk_bf16(o1[6], o1[7]);
                    w2.x = cvt_pk_bf16(o2[0], o2[1]); w2.y = cvt_pk_bf16(o2[2], o2[3]); w2.z = cvt_pk_bf16(o2[4], o2[5]); w2.w = cvt_pk_bf16(o2[6], o2[7]);
                    bf16_t* rp = base + (size_t)row * 1024;
                    *(u32x4*)(rp) = w1; *(u32x4*)(rp + HALF) = w2;
                }
        } else {
            const bool isv = pn < 16; const int colt = (isv ? pn - 8 : pn - 16) * BM;
            bf16_t* base = (isv ? V : G) + colt + c8;
#pragma unroll
            for (int ai = 0; ai < 2; ++ai)
#pragma unroll
                for (int m = 0; m < 4; ++m) { bf16_t* rowp = base + (size_t)(row0 + ai * HALF + m * 16) * 2048;
#pragma unroll
                    for (int bj = 0; bj < 2; ++bj) { f32x4 v0 = acc[ai][bj][m][0], v1 = acc[ai][bj][m][1];
                        if (!isv) {
#pragma unroll
                            for (int i = 0; i < 4; ++i) { v0[i] = silu_f(v0[i]); v1[i] = silu_f(v1[i]); } }
                        u32x4 w; w.x = cvt_pk_bf16(v0[0], v0[1]); w.y = cvt_pk_bf16(v0[2], v0[3]); w.z = cvt_pk_bf16(v1[0], v1[1]); w.w = cvt_pk_bf16(v1[2], v1[3]);
                        *(u32x4*)(rowp + bj * HALF) = w; } }
        }
    }
};

template <bool STORE> struct EpiGateT {
    static constexpr bool PERM = true, AFTER_DRAIN = false;
    bf16_t* O; int ldc; int pad;
    __device__ __forceinline__ void operator()(const f32x4 (&acc)[2][2][4][2], const Unit& u, int wr, int wc, int fr, int fq) const {
        const int row0 = u.pm * BM + wr * 64 + fr; const int col0 = u.pn * BM + wc * 32 + 8 * fq;
#pragma unroll
        for (int ai = 0; ai < 2; ++ai)
#pragma unroll
            for (int m = 0; m < 4; ++m) { bf16_t* rowp = O + (size_t)(row0 + ai * HALF + m * 16) * ldc + col0;
#pragma unroll
                for (int bj = 0; bj < 2; ++bj) { const f32x4 v0 = acc[ai][bj][m][0], v1 = acc[ai][bj][m][1];
                    const u32x4 ov = *(const u32x4*)(rowp + bj * HALF);
                    u32x4 w;
                    w.x = cvt_pk_bf16(silu_f(v0[0]) * bf_lo(ov.x), silu_f(v0[1]) * bf_hi(ov.x));
                    w.y = cvt_pk_bf16(silu_f(v0[2]) * bf_lo(ov.y), silu_f(v0[3]) * bf_hi(ov.y));
                    w.z = cvt_pk_bf16(silu_f(v1[0]) * bf_lo(ov.z), silu_f(v1[1]) * bf_hi(ov.z));
                    w.w = cvt_pk_bf16(silu_f(v1[2]) * bf_lo(ov.w), silu_f(v1[3]) * bf_hi(ov.w));
                    if (STORE) *(u32x4*)(rowp + bj * HALF) = w; else asm volatile("" :: "v"(w)); } }
    }
};

typedef EpiGateT<true> EpiGate;
template <class Epi, class Sched, bool ALIGN_EPI = false, bool SP2 = false>
__device__ __forceinline__ void gemm_phase(PG8_LAS unsigned char* lds, const Gemm g, const Sched& S, const Epi& E) {
    int tid_ = threadIdx.x; asm volatile("" : "+v"(tid_));
    const int tid = tid_, wid = __builtin_amdgcn_readfirstlane(tid >> 6), lane = tid & 63, wr = wid >> 2, wc = wid & 3, fr = lane & 15, fq = lane >> 4;
    const int K = g.K, nt = K / BK;
    unsigned voffA[2], voffB[2];
#pragma unroll
    for (int i = 0; i < 2; ++i) { int R, C; stage_rc(tid * 16 + i * 8192, R, C); const int Rb = Epi::PERM ? ((R & ~31) + perm32(R & 31)) : R;
        voffA[i] = (unsigned)(R * K + C) * 2u; voffB[i] = (unsigned)(Rb * K + C) * 2u; }
    const size_t kstep = (size_t)(BK * 2);
    const size_t hstep = (size_t)HALF * K * 2;
    const size_t tstep = 2 * hstep;
    const unsigned ldsw = (unsigned)wid * 1024u;
    const int aoff = lds_byte(wr * 64 + fr, fq * 8), boff = lds_byte(wc * 32 + fr, fq * 8);
#define PG8_SA(b, h) (((b) * 2 + (h)) * HTB)
#define PG8_SB(b, h) ((4 + (b) * 2 + (h)) * HTB)
#define PG8_STAGE(bufoff, gbase, voff) do { _Pragma("unroll") for (int _i = 0; _i < 2; ++_i) \
        __builtin_amdgcn_global_load_lds((const unsigned*)((const char*)(gbase) + (voff)[_i]), (PG8_LAS unsigned*)(lds + (bufoff) + ldsw + _i * 8192), 16, 0, 0); } while (0)
#define PG8_LDA(dst, b, h) do { _Pragma("unroll") for (int m = 0; m < 4; ++m) _Pragma("unroll") for (int k = 0; k < 2; ++k) dst[m][k] = *(const PG8_LAS bf16x8*)(lds + PG8_SA(b, h) + aoff + m * 2048 + k * 1024); } while (0)
#define PG8_LDB(dst, b, h) do { _Pragma("unroll") for (int n = 0; n < 2; ++n) _Pragma("unroll") for (int k = 0; k < 2; ++k) dst[n][k] = *(const PG8_LAS bf16x8*)(lds + PG8_SB(b, h) + boff + n * 2048 + k * 1024); } while (0)
#define PG8_MMA(ai, bj, At, Bt) do { __builtin_amdgcn_s_setprio(1); _Pragma("unroll") for (int m = 0; m < 4; ++m) _Pragma("unroll") for (int n = 0; n < 2; ++n) _Pragma("unroll") for (int k = 0; k < 2; ++k) \
        acc[ai][bj][m][n] = __builtin_amdgcn_mfma_f32_16x16x32_bf16(Bt[n][k], At[m][k], acc[ai][bj][m][n], 0, 0, 0); __builtin_amdgcn_s_setprio(0); } while (0)
#define PG8_WAIT_V(n) asm volatile("s_waitcnt vmcnt(" #n ")" ::: "memory")
#define PG8_WAIT_L(n) asm volatile("s_waitcnt lgkmcnt(" #n ")" ::: "memory")
#define PG8_BAR __builtin_amdgcn_s_barrier()
#define PG8_SCHED __builtin_amdgcn_sched_barrier(0)
    Unit cur, nxt; int ui = 0;
    if (!S.next(0, cur)) return;
    f32x4 acc[2][2][4][2];
#pragma unroll
    for (int a = 0; a < 2; ++a)
#pragma unroll
        for (int b = 0; b < 2; ++b)
#pragma unroll
            for (int m = 0; m < 4; ++m)
#pragma unroll
                for (int n = 0; n < 2; ++n) acc[a][b][m][n] = (f32x4){0.f, 0.f, 0.f, 0.f};
    bf16x8 At[4][2], B0[2][2], B1[2][2];
    const char* cA = (const char*)g.A + (size_t)cur.pm * tstep; const char* cB = (const char*)g.Bt + (size_t)cur.pn * tstep;
    S.a_ready(cur);
    if constexpr (SP2) {
        PG8_STAGE(PG8_SB(0, 0), cB, voffB); PG8_STAGE(PG8_SB(0, 1), cB + hstep, voffB); PG8_STAGE(PG8_SA(0, 0), cA, voffA); PG8_STAGE(PG8_SA(0, 1), cA + hstep, voffA);
        if (wr == 1) PG8_BAR;
        PG8_WAIT_V(2); PG8_BAR;
        PG8_STAGE(PG8_SB(1, 0), cB + kstep, voffB); PG8_STAGE(PG8_SA(1, 0), cA + kstep, voffA); PG8_STAGE(PG8_SB(1, 1), cB + hstep + kstep, voffB);
        PG8_WAIT_V(6); PG8_BAR;
    } else {
        PG8_STAGE(PG8_SB(0, 0), cB, voffB); PG8_STAGE(PG8_SA(0, 0), cA, voffA); PG8_STAGE(PG8_SB(0, 1), cB + hstep, voffB); PG8_STAGE(PG8_SA(0, 1), cA + hstep, voffA);
        if (wr == 1) PG8_BAR;
        PG8_WAIT_V(4); PG8_BAR;
        PG8_STAGE(PG8_SB(1, 0), cB + kstep, voffB); PG8_STAGE(PG8_SA(1, 0), cA + kstep, voffA); PG8_STAGE(PG8_SB(1, 1), cB + hstep + kstep, voffB);
        PG8_WAIT_V(6); PG8_BAR;
    }
    for (;;) {
        const bool has_next = S.next(ui + 1, nxt);
        const char* nA = has_next ? (const char*)g.A + (size_t)nxt.pm * tstep : cA; const char* nB = has_next ? (const char*)g.Bt + (size_t)nxt.pn * tstep : cB;
        for (int t = 0; t < nt; t += 2) {
            const bool last = (t == nt - 2);
            const char* a1 = cA + (size_t)(t + 1) * kstep;
            const char* a2 = last ? nA : cA + (size_t)(t + 2) * kstep; const char* b2 = last ? nB : cB + (size_t)(t + 2) * kstep;
            const char* a3 = a2 + kstep; const char* b3 = b2 + kstep;
            if (last && has_next) S.a_ready(nxt);
            if constexpr (SP2) {
            PG8_LDB(B0, 0, 0); PG8_LDB(B1, 0, 1); PG8_SCHED; PG8_LDA(At, 0, 0); PG8_STAGE(PG8_SA(1, 1), a1 + hstep, voffA);
            PG8_WAIT_V(8); PG8_WAIT_L(0); PG8_BAR; PG8_MMA(0, 0, At, B0); PG8_MMA(0, 1, At, B1); PG8_BAR; PG8_SCHED;
            PG8_LDA(At, 0, 1); PG8_STAGE(PG8_SB(0, 0), b2, voffB); PG8_STAGE(PG8_SB(0, 1), b2 + hstep, voffB); PG8_STAGE(PG8_SA(0, 0), a2, voffA);
            PG8_WAIT_V(8); PG8_WAIT_L(0); PG8_BAR; PG8_MMA(1, 0, At, B0); PG8_MMA(1, 1, At, B1); PG8_BAR; PG8_SCHED;
            PG8_LDB(B0, 1, 0); PG8_LDB(B1, 1, 1); PG8_SCHED; PG8_LDA(At, 1, 0); PG8_STAGE(PG8_SA(0, 1), a2 + hstep, voffA);
            PG8_WAIT_V(8); PG8_WAIT_L(0); PG8_BAR; PG8_MMA(0, 0, At, B0); PG8_MMA(0, 1, At, B1); PG8_BAR; PG8_SCHED;
            PG8_LDA(At, 1, 1); PG8_STAGE(PG8_SB(1, 0), b3, voffB); PG8_STAGE(PG8_SB(1, 1), b3 + hstep, voffB); PG8_STAGE(PG8_SA(1, 0), a3, voffA);
            PG8_WAIT_V(8); PG8_WAIT_L(0); PG8_BAR; PG8_MMA(1, 0, At, B0); PG8_MMA(1, 1, At, B1); PG8_BAR; PG8_SCHED;
            } else {
            PG8_LDB(B0, 0, 0); PG8_SCHED; PG8_LDA(At, 0, 0); PG8_STAGE(PG8_SA(1, 1), a1 + hstep, voffA);
            PG8_WAIT_L(8); PG8_BAR; PG8_WAIT_L(0); PG8_MMA(0, 0, At, B0); PG8_BAR; PG8_SCHED;
            PG8_LDB(B1, 0, 1); PG8_STAGE(PG8_SB(0, 0), b2, voffB);
            PG8_BAR; PG8_WAIT_L(0); PG8_MMA(0, 1, At, B1); PG8_BAR;
            PG8_LDA(At, 0, 1); PG8_STAGE(PG8_SA(0, 0), a2, voffA);
            PG8_BAR; PG8_WAIT_L(0); PG8_MMA(1, 0, At, B0); PG8_BAR; PG8_SCHED;
            PG8_STAGE(PG8_SB(0, 1), b2 + hstep, voffB);
            PG8_WAIT_V(6); PG8_BAR; PG8_MMA(1, 1, At, B1); PG8_BAR;
            PG8_LDB(B0, 1, 0); PG8_SCHED; PG8_LDA(At, 1, 0); PG8_STAGE(PG8_SA(0, 1), a2 + hstep, voffA);
            PG8_WAIT_L(8); PG8_BAR; PG8_WAIT_L(0); PG8_MMA(0, 0, At, B0); PG8_BAR; PG8_SCHED;
            PG8_LDB(B1, 1, 1); PG8_STAGE(PG8_SB(1, 0), b3, voffB);
            PG8_BAR; PG8_WAIT_L(0); PG8_MMA(0, 1, At, B1); PG8_BAR;
            PG8_LDA(At, 1, 1); PG8_STAGE(PG8_SA(1, 0), a3, voffA);
            PG8_BAR; PG8_WAIT_L(0); PG8_MMA(1, 0, At, B0); PG8_BAR; PG8_SCHED;
            PG8_STAGE(PG8_SB(1, 1), b3 + hstep, voffB);
            PG8_WAIT_V(6); PG8_BAR; PG8_MMA(1, 1, At, B1); PG8_BAR;
            }
        }
        if constexpr (ALIGN_EPI) { if (wr == 0) PG8_BAR; }
        if constexpr (!Epi::AFTER_DRAIN) { E(acc, cur, wr, wc, fr, fq); S.done(cur); }
        if (!has_next) break;
#pragma unroll
        for (int a = 0; a < 2; ++a)
#pragma unroll
            for (int b = 0; b < 2; ++b)
#pragma unroll
                for (int m = 0; m < 4; ++m)
#pragma unroll
                    for (int n = 0; n < 2; ++n) acc[a][b][m][n] = (f32x4){0.f, 0.f, 0.f, 0.f};
        cur = nxt; cA = nA; cB = nB; ++ui;
        if constexpr (ALIGN_EPI) { if (wr == 1) PG8_BAR; }
    }
    PG8_WAIT_V(0);
    if constexpr (!ALIGN_EPI) { if (wr == 0) PG8_BAR; }
    PG8_BAR;
    if constexpr (Epi::AFTER_DRAIN) { E.fused(acc, cur, wr, wc, fr, fq, lds, wid, lane); S.done(cur); }
#undef PG8_SA
#undef PG8_SB
#undef PG8_STAGE
#undef PG8_LDA
#undef PG8_LDB
#undef PG8_MMA
#undef PG8_WAIT_V
#undef PG8_WAIT_L
#undef PG8_BAR
#undef PG8_SCHED
}
}

#define PG8_SP2 true
#define PG8_ALIGN true

constexpr int BATCH = 2, SEQ = 8192, DM = 1024, DI = 2048, MROWS = BATCH * SEQ;
constexpr int RH = 4, RDK = 256, RDV = 512, RCH = 128;
constexpr int RET_COLS = 6144;
constexpr int AH = 16, AD = 64, ADV = 128;
constexpr int DIFF_QKV_COLS = 6144, DIFF_COLS = 8192;
constexpr float RMS_EPS = 1e-6f, GN_EPS = 1e-5f;
constexpr float LOG2E = 1.4426950408889634f;
constexpr float LAMBDA_INIT = 0.35550906759096926f;
constexpr float QSCALE2 = 0.125f * LOG2E;
constexpr int NWAVES = 8, NTHREADS = 512;

constexpr size_t MiB = 1u << 20;
constexpr size_t WS_CTL = 0, CTL_ZERO_BYTES = 1 * MiB;
constexpr size_t WS_XCH = 2 * MiB;
constexpr size_t WS_W0IN = 4 * MiB;
constexpr size_t WS_W0OUT = 16 * MiB;
constexpr size_t WS_XN = 20 * MiB;
constexpr size_t WS_Q0 = 52 * MiB, WS_K0 = 84 * MiB, WS_V0 = 116 * MiB, WS_G0 = 180 * MiB;
constexpr size_t WS_Q1 = 52 * MiB, WS_K1 = 116 * MiB, WS_V1 = 180 * MiB;
constexpr size_t WS_YF_L0 = 52 * MiB;
constexpr size_t WS_YF_L1 = 116 * MiB;
constexpr size_t WS_W1G = 244 * MiB;
constexpr size_t WS_W1OUT = 248 * MiB;
constexpr size_t WS_END = 256 * MiB;
constexpr int CW_TMO = 0, CW_CODE = 1;
constexpr int CW_BAR = 4096;
constexpr int CW_SEAM = 16384, SEAM_BANK = 128 * 64;

typedef unsigned short bf16;
typedef unsigned v4u __attribute__((ext_vector_type(4)));
typedef float f32x4 __attribute__((ext_vector_type(4)));
#define GAS __attribute__((address_space(1)))
#define LAS __attribute__((address_space(3)))
typedef GAS unsigned gu32;
typedef GAS unsigned long long gu64;
#define RLX_AGENT __ATOMIC_RELAXED, __HIP_MEMORY_SCOPE_AGENT
#define LDS_WAIT() asm volatile("s_waitcnt lgkmcnt(0)" ::: "memory")
#define VM_WAIT() asm volatile("s_waitcnt vmcnt(0)" ::: "memory")

__device__ __forceinline__ unsigned f2bf(float f) { unsigned u = __builtin_bit_cast(unsigned, f); return (u + 0x7fffu + ((u >> 16) & 1u)) >> 16; }
__device__ __forceinline__ unsigned pk2(float lo, float hi) { return f2bf(lo) | (f2bf(hi) << 16); }
__device__ __forceinline__ float bf2f(bf16 h) { return __uint_as_float((unsigned)h << 16); }
using pg8::bf_lo; using pg8::bf_hi;
__device__ __forceinline__ float wave_sum(float v) {
#pragma unroll
    for (int o = 1; o < 64; o <<= 1) v += __shfl_xor(v, o);
    return v;
}

__device__ __forceinline__ void transpose_item(const float* W, int K, int N, bf16* WT, int n_lo, LAS float* scr, int item, int lane) {
    const int nblk = N / 32, kb = item / nblk, nb = item % nblk, k0 = 64 * kb, n0 = 32 * nb;
#pragma unroll 8
    for (int i = 0; i < 32; ++i) { const int kk = 2 * i + (lane >> 5); scr[kk * 33 + (lane & 31)] = W[(size_t)(k0 + kk) * N + n0 + (lane & 31)]; }
    LDS_WAIT(); asm volatile("" ::: "memory");
    const int c = lane & 7;
#pragma unroll
    for (int j = 0; j < 4; ++j) { const int n = (lane >> 3) + 8 * j; const LAS float* s = scr + (8 * c) * 33 + n;
        v4u o; o.x = pk2(s[0 * 33], s[1 * 33]); o.y = pk2(s[2 * 33], s[3 * 33]); o.z = pk2(s[4 * 33], s[5 * 33]); o.w = pk2(s[6 * 33], s[7 * 33]);
        *(v4u*)(WT + (size_t)(n0 + n - n_lo) * K + k0 + 8 * c) = o; }
    LDS_WAIT(); asm volatile("" ::: "memory");
}
__device__ __forceinline__ void transpose_all(const float* W, int K, int N, bf16* WT, int n_lo, int n_hi, LAS float* scr, int gw, int NGW, int lane) {
    const int nblk = N / 32, nsel = (n_hi - n_lo) / 32, nitems = (K / 64) * nsel;
    for (int it = gw; it < nitems; it += NGW) {
        const int kb = it / nsel, nb = it % nsel + n_lo / 32;
        transpose_item(W, K, N, WT, n_lo, scr, kb * nblk + nb, lane);
    }
}

__device__ __forceinline__ void norm_rows(const float* y, const float* base, const float* gpost, const float* gpre, float* out, bf16* xn, int mode, int gw, int NGW, int lane) {
    for (int m = gw; m < MROWS; m += NGW) {
        const f32x4* yr = (const f32x4*)(y + (size_t)m * DM) + lane;
        f32x4 v[4]; float s = 0.f;
#pragma unroll
        for (int j = 0; j < 4; ++j) { v[j] = yr[64 * j]; s += (v[j].x * v[j].x + v[j].y * v[j].y) + (v[j].z * v[j].z + v[j].w * v[j].w); }
        const float rstd = 1.0f / sqrtf(wave_sum(s) * (1.0f / DM) + RMS_EPS);
        if (mode == 0) {
            unsigned long long* o8 = (unsigned long long*)(xn + (size_t)m * DM) + lane;
#pragma unroll
            for (int j = 0; j < 4; ++j) { const f32x4 g = ((const f32x4*)gpre)[64 * j + lane];
                o8[64 * j] = (unsigned long long)pk2(v[j].x * rstd * g.x, v[j].y * rstd * g.y) | ((unsigned long long)pk2(v[j].z * rstd * g.z, v[j].w * rstd * g.w) << 32); }
        } else {
            const f32x4* br = (const f32x4*)(base + (size_t)m * DM) + lane; f32x4* orow = (f32x4*)(out + (size_t)m * DM) + lane;
            float s2 = 0.f;
#pragma unroll
            for (int j = 0; j < 4; ++j) { const f32x4 g = ((const f32x4*)gpost)[64 * j + lane]; const f32x4 b = br[64 * j];
                v[j] = b + v[j] * rstd * g; orow[64 * j] = v[j];
                s2 += (v[j].x * v[j].x + v[j].y * v[j].y) + (v[j].z * v[j].z + v[j].w * v[j].w); }
            if (mode == 1) {
                const float r2 = 1.0f / sqrtf(wave_sum(s2) * (1.0f / DM) + RMS_EPS);
                unsigned long long* o8 = (unsigned long long*)(xn + (size_t)m * DM) + lane;
#pragma unroll
                for (int j = 0; j < 4; ++j) { const f32x4 g = ((const f32x4*)gpre)[64 * j + lane];
                    o8[64 * j] = (unsigned long long)pk2(v[j].x * r2 * g.x, v[j].y * r2 * g.y) | ((unsigned long long)pk2(v[j].z * r2 * g.z, v[j].w * r2 * g.w) << 32); }
            }
        }
    }
}

__device__ __forceinline__ void gn_gate_rows(const bf16* RET, bf16* G, int gw, int NGW, int lane) {
    for (int it = gw; it < MROWS * RH; it += NGW) {
        const size_t off = (size_t)it * RDV + lane * 8;
        const v4u rv = *(const v4u*)(RET + off); const v4u gv = *(const v4u*)(G + off);
        float x[8] = {bf_lo(rv.x), bf_hi(rv.x), bf_lo(rv.y), bf_hi(rv.y), bf_lo(rv.z), bf_hi(rv.z), bf_lo(rv.w), bf_hi(rv.w)};
        float g[8] = {bf_lo(gv.x), bf_hi(gv.x), bf_lo(gv.y), bf_hi(gv.y), bf_lo(gv.z), bf_hi(gv.z), bf_lo(gv.w), bf_hi(gv.w)};
        float s = 0.f;
#pragma unroll
        for (int j = 0; j < 8; ++j) s += x[j];
        const float mu = wave_sum(s) * (1.0f / RDV);
        float q = 0.f;
#pragma unroll
        for (int j = 0; j < 8; ++j) { x[j] -= mu; q += x[j] * x[j]; }
        const float rstd = 1.0f / sqrtf(wave_sum(q) * (1.0f / RDV) + GN_EPS);
        v4u o; o.x = pk2(x[0] * rstd * g[0], x[1] * rstd * g[1]); o.y = pk2(x[2] * rstd * g[2], x[3] * rstd * g[3]);
        o.z = pk2(x[4] * rstd * g[4], x[5] * rstd * g[5]); o.w = pk2(x[6] * rstd * g[6], x[7] * rstd * g[7]);
        *(v4u*)(G + off) = o;
    }
}
__device__ __forceinline__ int t5_bucket(int n) {
    if (n < 16) return n;
    int l = 16 + (int)(logf((float)n / 16.0f) / 2.0794415416798357f * 16.0f);
    return l < 31 ? l : 31;
}
__device__ __forceinline__ float ret_lg(int h) { return log1pf(-exp2f(-5.0f - (float)h)); }
#define XB_TMO      128
#define XB_XCNT(j)  (256  + 64 * (j))
#define XB_XSUB(j)  (1280 + 64 * (j))
#define XB_XGEN(j)  (2304 + 64 * (j))
#define XB_TOP      3328
#define XB_TOPGEN   3392
#define XCD_BAR_WORDS 3456
#define XB_SPIN_CAP (1u << 26)

__device__ __forceinline__ unsigned xb_ld(unsigned* p)              { return __hip_atomic_load(p, __ATOMIC_RELAXED, __HIP_MEMORY_SCOPE_AGENT); }
__device__ __forceinline__ unsigned xb_add(unsigned* p, unsigned v) { return __hip_atomic_fetch_add(p, v, __ATOMIC_RELAXED, __HIP_MEMORY_SCOPE_AGENT); }
__device__ __forceinline__ unsigned xb_xcc_id() { return (unsigned)__builtin_amdgcn_s_getreg((3 << 11) | 20) & 0xFu; }
#define XB_SPIN(cond, bar) do { unsigned _sp = 0; while (cond) { __builtin_amdgcn_s_sleep(1); \
    if ((++_sp & 255u) == 0u) { if (xb_ld(&(bar)[XB_TMO])) break; if (_sp > XB_SPIN_CAP) { atomicAdd(&(bar)[XB_TMO], 1u); break; } } } } while (0)

struct XcdBarrier {
    unsigned* bar; unsigned x;
    volatile LAS unsigned* st;
};

__device__ __forceinline__ XcdBarrier xcd_barrier_post(unsigned* bar, volatile LAS unsigned* st) {
    XcdBarrier b; b.bar = bar; b.x = xb_xcc_id(); b.st = st;
    if (threadIdx.x == 0) (void)xb_add(&bar[XB_XCNT(b.x)], 1u);
    return b;
}
__device__ __forceinline__ void xcd_barrier_complete(unsigned* bar, unsigned x, unsigned& nloc, unsigned& nx) {
    const unsigned G = gridDim.x * gridDim.y * gridDim.z;
    unsigned sum, cnt, mine, sp = 0u;
    for (;;) {
        sum = 0u; cnt = 0u; mine = 0u;
#pragma unroll
        for (unsigned j = 0; j < 16; ++j) { const unsigned c = xb_ld(&bar[XB_XCNT(j)]); sum += c; cnt += (c > 0u) ? 1u : 0u; mine = (j == x) ? c : mine; }
        if (sum == G) break;
        __builtin_amdgcn_s_sleep(1);
        if ((++sp & 255u) == 0u) { if (xb_ld(&bar[XB_TMO])) break; if (sp > XB_SPIN_CAP) { atomicAdd(&bar[XB_TMO], 1u); break; } }
    }
    nloc = mine > 0u ? mine : 1u; nx = cnt > 0u ? cnt : 1u;
}

__device__ __forceinline__ void xcd_barrier(const XcdBarrier& b) {
    asm volatile("s_waitcnt vmcnt(0)" ::: "memory");
    __syncthreads();
    if (threadIdx.x == 0) {
        unsigned* bar = b.bar;
        __builtin_amdgcn_s_waitcnt(0);
        unsigned nloc = b.st[0], nx = b.st[1];
        if (nloc == 0u) { xcd_barrier_complete(bar, b.x, nloc, nx); b.st[0] = nloc; b.st[1] = nx; }
        const unsigned old = xb_add(&bar[XB_XSUB(b.x)], 1u);
        const unsigned gen = old / nloc;
        if (old + 1u == (gen + 1u) * nloc) {
            __builtin_amdgcn_fence(__ATOMIC_RELEASE, "agent");
            asm volatile("s_waitcnt vmcnt(0)" ::: "memory");
            const unsigned og = xb_add(&bar[XB_TOP], 1u);
            const unsigned tg = og / nx;
            if (og + 1u == (tg + 1u) * nx) xb_add(&bar[XB_TOPGEN], 1u);
            else XB_SPIN(xb_ld(&bar[XB_TOPGEN]) == tg, bar);
            __builtin_amdgcn_fence(__ATOMIC_ACQUIRE, "agent");
            xb_add(&bar[XB_XGEN(b.x)], 1u);
            asm volatile("s_waitcnt vmcnt(0)" ::: "memory");
        } else {
            XB_SPIN(xb_ld(&bar[XB_XGEN(b.x)]) == gen, bar);
            __builtin_amdgcn_fence(__ATOMIC_ACQUIRE, "agent");
            asm volatile("s_waitcnt vmcnt(0)" ::: "memory");
        }
    }
    __syncthreads();
}


__device__ __forceinline__ void nret_scores(const bf16* Q, const bf16* K, float* S, int n, int gtid, int NT) {
    for (int idx = gtid; idx < 8 * 128 * 128; idx += NT) {
        const int j = idx & 127, i = (idx >> 7) & 127, bh = idx >> 14, b = bh >> 2, h = bh & 3;
        const bf16* q = Q + (size_t)(b * SEQ + n * RCH + i) * 1024 + h * RDK;
        const bf16* k = K + (size_t)(b * SEQ + n * RCH + j) * 1024 + h * RDK;
        float s = 0.f;
        for (int d = 0; d < RDK; ++d) s += bf2f(q[d]) * bf2f(k[d]);
        S[idx] = s;
    }
}
__device__ __forceinline__ void nret_out(const bf16* Q, const bf16* V, const float* S, const float* R, bf16* RET, int n, int gtid, int NT) {
    for (int idx = gtid; idx < 8 * 128 * 512; idx += NT) {
        const int e = idx & 511, i = (idx >> 9) & 127, bh = idx >> 16, b = bh >> 2, h = bh & 3;
        const float lg = ret_lg(h);
        const float* Srow = S + ((size_t)bh * 128 + i) * 128;
        float acc = 0.f;
        for (int j = 0; j <= i; ++j) acc += expf(lg * (float)(i - j)) * Srow[j] * bf2f(V[(size_t)(b * SEQ + n * RCH + j) * 2048 + h * RDV + e]);
        const bf16* q = Q + (size_t)(b * SEQ + n * RCH + i) * 1024 + h * RDK;
        const float* Rb = R + (size_t)bh * RDK * RDV + e;
        float cr = 0.f;
        if (n > 0) for (int d = 0; d < RDK; ++d) cr += bf2f(q[d]) * Rb[(size_t)d * RDV];
        acc += expf(lg * (float)(i + 1)) * cr;
        RET[(size_t)(b * SEQ + n * RCH + i) * 2048 + h * RDV + e] = (bf16)f2bf(acc);
    }
}
__device__ __forceinline__ void nret_state(const bf16* K, const bf16* V, float* R, int n, int gtid, int NT) {
    for (int idx = gtid; idx < 8 * 256 * 512; idx += NT) {
        const int e = idx & 511, d = (idx >> 9) & 255, bh = idx >> 17, b = bh >> 2, h = bh & 3;
        const float lg = ret_lg(h);
        float acc = 0.f;
        for (int j = 0; j < RCH; ++j) acc += expf(lg * (float)(RCH - 1 - j)) * bf2f(K[(size_t)(b * SEQ + n * RCH + j) * 1024 + h * RDK + d]) * bf2f(V[(size_t)(b * SEQ + n * RCH + j) * 2048 + h * RDV + e]);
        R[idx] = (n == 0 ? 0.f : expf(lg * (float)RCH) * R[idx]) + acc;
    }
}

__device__ __forceinline__ void nattn_block(int blk, bf16* Q, const bf16* K, const bf16* V, float lam, const float* subln_g, const float* rel_bias,
                                            LAS float* o1s, LAS float* btab, int lane) {
    const int qb = blk & 127, bh = blk >> 7, b = bh >> 4, h = bh & 15;
    const int t = qb * 64 + lane;
    btab[lane] = rel_bias[t5_bucket(lane) * 16 + h] * LOG2E; btab[lane + 64] = rel_bias[t5_bucket(lane + 64) * 16 + h] * LOG2E;
    LDS_WAIT(); __builtin_amdgcn_wave_barrier();
    const int kmax = qb * 64 + 63;
    float ss = 0.f;
    for (int map = 0; map < 2; ++map) {
        float q[64];
        const v4u* qp = (const v4u*)(Q + (size_t)(b * SEQ + t) * 2048 + h * 128 + map * 64);
#pragma unroll
        for (int c = 0; c < 8; ++c) { const v4u w = qp[c]; q[8*c] = bf_lo(w.x); q[8*c+1] = bf_hi(w.x); q[8*c+2] = bf_lo(w.y); q[8*c+3] = bf_hi(w.y);
            q[8*c+4] = bf_lo(w.z); q[8*c+5] = bf_hi(w.z); q[8*c+6] = bf_lo(w.w); q[8*c+7] = bf_hi(w.w); }
        float mx = -INFINITY;
        for (int k = 0; k <= kmax; ++k) {
            const v4u* kp = (const v4u*)(K + (size_t)(b * SEQ + k) * 2048 + h * 128 + map * 64);
            float s = 0.f;
#pragma unroll
            for (int c = 0; c < 8; ++c) { const v4u w = kp[c];
                s += q[8*c] * bf_lo(w.x) + q[8*c+1] * bf_hi(w.x) + q[8*c+2] * bf_lo(w.y) + q[8*c+3] * bf_hi(w.y)
                   + q[8*c+4] * bf_lo(w.z) + q[8*c+5] * bf_hi(w.z) + q[8*c+6] * bf_lo(w.w) + q[8*c+7] * bf_hi(w.w); }
            const int dist = t - k;
            if (dist >= 0) { s += btab[dist < 127 ? dist : 127]; mx = fmaxf(mx, s); }
        }
        for (int half = 0; half < 2; ++half) {
            float o[64];
#pragma unroll
            for (int e = 0; e < 64; ++e) o[e] = 0.f;
            float l = 0.f;
            for (int k = 0; k <= kmax; ++k) {
                const v4u* kp = (const v4u*)(K + (size_t)(b * SEQ + k) * 2048 + h * 128 + map * 64);
                float s = 0.f;
#pragma unroll
                for (int c = 0; c < 8; ++c) { const v4u w = kp[c];
                    s += q[8*c] * bf_lo(w.x) + q[8*c+1] * bf_hi(w.x) + q[8*c+2] * bf_lo(w.y) + q[8*c+3] * bf_hi(w.y)
                       + q[8*c+4] * bf_lo(w.z) + q[8*c+5] * bf_hi(w.z) + q[8*c+6] * bf_lo(w.w) + q[8*c+7] * bf_hi(w.w); }
                const int dist = t - k;
                float p = 0.f;
                if (dist >= 0) { s += btab[dist < 127 ? dist : 127]; p = exp2f(s - mx); }
                l += p;
                const v4u* vp = (const v4u*)(V + (size_t)(b * SEQ + k) * 2048 + h * 128 + half * 64);
#pragma unroll
                for (int c = 0; c < 8; ++c) { const v4u w = vp[c];
                    o[8*c] += p * bf_lo(w.x); o[8*c+1] += p * bf_hi(w.x); o[8*c+2] += p * bf_lo(w.y); o[8*c+3] += p * bf_hi(w.y);
                    o[8*c+4] += p * bf_lo(w.z); o[8*c+5] += p * bf_hi(w.z); o[8*c+6] += p * bf_lo(w.w); o[8*c+7] += p * bf_hi(w.w); }
            }
            const float linv = 1.0f / l;
            if (map == 0) {
#pragma unroll
                for (int e = 0; e < 64; ++e) o1s[(half * 64 + e) * 64 + lane] = o[e] * linv;
            } else {
#pragma unroll
                for (int e = 0; e < 64; ++e) { const float d = o1s[(half * 64 + e) * 64 + lane] - lam * (o[e] * linv); ss += d * d; o1s[(half * 64 + e) * 64 + lane] = d; }
            }
        }
    }
    {
        const float r = 1.0f / sqrtf(ss * (1.0f / 128.0f) + GN_EPS) * (1.0f - LAMBDA_INIT);
        bf16* op = Q + (size_t)(b * SEQ + t) * 2048 + h * 128;
#pragma unroll 8
        for (int e = 0; e < 128; e += 2) *(unsigned*)(op + e) = pk2(o1s[e * 64 + lane] * r * subln_g[e], o1s[(e + 1) * 64 + lane] * r * subln_g[e + 1]);
    }
    LDS_WAIT(); __builtin_amdgcn_wave_barrier();
}
__device__ __forceinline__ float diff_lambda(const float* lq1, const float* lk1, const float* lq2, const float* lk2) {
    float d1 = 0.f, d2 = 0.f;
    for (int i = 0; i < 64; ++i) { d1 += lq1[i] * lk1[i]; d2 += lq2[i] * lk2[i]; }
    return expf(d1) - expf(d2) + LAMBDA_INIT;
}

namespace da {
using bf16x8 = __attribute__((ext_vector_type(8))) short;
using s16x4 = __attribute__((ext_vector_type(4))) short;
using f32x16 = __attribute__((ext_vector_type(16))) float;
using u32x4 = __attribute__((ext_vector_type(4))) unsigned;
typedef short v4i16_t __attribute__((ext_vector_type(4)));
typedef LAS const char* lds_cptr;
constexpr int PITCH = 2048, KVB = 64, SLOT = 32768, OFF_K0 = 0, OFF_K1 = 8192, OFF_V = 16384;
constexpr int NSLOT = 4;
constexpr int LDS_WS = 131072;
constexpr int LDS_BT = 133120;
constexpr int LDS_X = 0;
constexpr int LDS_OST = 65536;
constexpr float THR = 8.0f;
#define DA_SBAR() __builtin_amdgcn_sched_barrier(0)
#define DA_MFMA(a, b, c) __builtin_amdgcn_mfma_f32_32x32x16_bf16(a, b, c, 0, 0, 0)
#define DA_WAIT_BAR(N) asm volatile("s_waitcnt vmcnt(" #N ") lgkmcnt(0)\n\ts_barrier" ::: "memory")
__device__ __forceinline__ int crow(int r, int hi) { return (r & 3) + 8 * (r >> 2) + 4 * hi; }
__device__ __forceinline__ void glds16(const void* gsrc, unsigned lds_dst) { unsigned keep;
    asm volatile("s_mov_b32 %0, m0\n\ts_mov_b32 m0, %2\n\ts_nop 0\n\tglobal_load_lds_dwordx4 %1, off\n\ts_mov_b32 m0, %0" : "=&s"(keep) : "v"(gsrc), "s"(lds_dst) : "memory"); }
__device__ __forceinline__ s16x4 vtr(lds_cptr p) { return __builtin_bit_cast(s16x4, __builtin_amdgcn_ds_read_tr16_b64_v4i16((LAS v4i16_t*)p)); }
__device__ __forceinline__ unsigned cvtpk(float lo, float hi) { typedef float f2 __attribute__((ext_vector_type(2))); typedef __bf16 b2 __attribute__((ext_vector_type(2)));
    f2 v = {lo, hi}; b2 b = __builtin_convertvector(v, b2); return __builtin_bit_cast(unsigned, b); }
#define DA_MX3(a, b, c) __builtin_fmaxf(__builtin_fmaxf((a), (b)), (c))
__device__ __forceinline__ float rowmax(const f32x16& p0, const f32x16& p1) {
    float a = DA_MX3(p0[0], p0[1], p1[0]), b = DA_MX3(p0[2], p0[3], p1[1]); a = DA_MX3(a, p1[2], p1[3]);
#pragma unroll
    for (int r = 4; r < 16; r += 4) { a = DA_MX3(a, p0[r], p0[r + 1]); b = DA_MX3(b, p0[r + 2], p0[r + 3]); a = DA_MX3(a, p1[r], p1[r + 1]); b = DA_MX3(b, p1[r + 2], p1[r + 3]); }
    float m = __builtin_fmaxf(a, b); auto rr = __builtin_amdgcn_permlane32_swap(__float_as_uint(m), __float_as_uint(m), false, false);
    return __builtin_fmaxf(__uint_as_float(rr[0]), __uint_as_float(rr[1])); }

template <bool STORE, int MODE = 0> __device__ __forceinline__ void attn_unit(int b, int h, int qb, bf16* Q, const bf16* K, const bf16* V, float lam, const float* subln_g, LAS char* shm) {
    int tid_ = threadIdx.x; asm volatile("" : "+v"(tid_));
    const int tid = tid_, lane = tid & 63, r32 = lane & 31, hi = lane >> 5; const int wid = __builtin_amdgcn_readfirstlane(tid >> 6);
    const int map = wid >> 2, qblk = wid & 3;
    const long rowbase = (long)b * SEQ; const int q0 = qb * 128; const int NT = 2 * qb + 2;
    const bf16* Qw = Q + (rowbase + q0 + qblk * 32) * PITCH + h * 128 + map * 64;
    const bf16* Kh = K + rowbase * PITCH + h * 128; const bf16* Vh = V + rowbase * PITCH + h * 128;
    const unsigned lds0 = (unsigned)(uintptr_t)shm;
    LAS float* wsf = (LAS float*)(shm + LDS_WS) + wid * 64;
    const LAS float* btab = (const LAS float*)(shm + LDS_BT);
    const bf16* ksrc = Kh + (long)lane * PITCH + wid * 8;
    const bf16* vsrc = Vh + (long)(16 * (wid & 3) + (lane >> 2)) * PITCH + (wid >> 2) * 32 + (lane & 3) * 8;
    const unsigned kdst = lds0 + OFF_K0 + wid * 1024, vdst = lds0 + OFF_V + wid * 1024;
#define DA_DMA(t, slot) do { if (MODE >= 2) break; const long go_ = (long)(t) * KVB * PITCH; const unsigned so_ = (unsigned)(slot); \
        glds16(ksrc + go_, (unsigned)__builtin_amdgcn_readfirstlane(kdst + so_)); glds16(ksrc + go_ + 64, (unsigned)__builtin_amdgcn_readfirstlane(kdst + so_ + 8192)); \
        glds16(vsrc + go_, (unsigned)__builtin_amdgcn_readfirstlane(vdst + so_)); glds16(vsrc + go_ + 64, (unsigned)__builtin_amdgcn_readfirstlane(vdst + so_ + 8192)); } while (0)
    const lds_cptr kp0 = (lds_cptr)shm + (map ? OFF_K1 : OFF_K0) + hi * 1024 + r32 * 16;
    const lds_cptr vp0 = (lds_cptr)shm + OFF_V + ((lane >> 4) & 1) * 32 + (lane & 3) * 8 + (4 * hi + ((lane & 15) >> 2)) * 64;
    DA_DMA(0, 0); DA_DMA(1, SLOT); if (NT > 2) DA_DMA(2, 2 * SLOT);
    bf16x8 qr[4];
#pragma unroll
    for (int d0 = 0; d0 < 4; ++d0) qr[d0] = *reinterpret_cast<const bf16x8*>(&Qw[(long)r32 * PITCH + d0 * 16 + hi * 8]);
    float mhat = 0.f, l_reg = 0.f;
    f32x16 o[4];
#pragma unroll
    for (int g = 0; g < 4; ++g) o[g] = f32x16{};
    bool moved = false;
    const f32x16 zero16 = f32x16{};
    const int qpos = q0 + qblk * 32 + r32;
#pragma unroll
    for (int d0 = 0; d0 < 4; ++d0) asm volatile("" : "+v"(qr[d0]));
#define DA_VLOAD(dst, g_) do { _Pragma("unroll") for (int ks_ = 0; ks_ < 4; ++ks_) { const s16x4 lo_ = vtr(vp + (g_) * 4096 + ks_ * 1024), hh_ = vtr(vp + (g_) * 4096 + ks_ * 1024 + 512); \
        dst[ks_] = (bf16x8){lo_[0], lo_[1], lo_[2], lo_[3], hh_[0], hh_[1], hh_[2], hh_[3]}; } } while (0)
#define DA_KLOAD(t) do { const lds_cptr kp_ = kp0 + ((t) & 3) * SLOT; \
        _Pragma("unroll") for (int j = 0; j < 4; ++j) { kf[2 * j] = *(const LAS bf16x8*)(kp_ + j * 2048); kf[2 * j + 1] = *(const LAS bf16x8*)(kp_ + j * 2048 + 512); } } while (0)
    if (NT > 2) { DA_WAIT_BAR(8); } else { DA_WAIT_BAR(4); }
    if (NT > 3) DA_DMA(3, 3 * SLOT);
    bf16x8 kf[8];
    DA_KLOAD(0);
#pragma unroll 1
    for (int t = 0; t < NT; ++t) {
        const lds_cptr vp = vp0 + (t & 3) * SLOT;
        f32x16 c0, c1;
        c0 = DA_MFMA(kf[0], qr[0], zero16); c1 = DA_MFMA(kf[1], qr[0], zero16);
        c0 = DA_MFMA(kf[2], qr[1], c0); c1 = DA_MFMA(kf[3], qr[1], c1);
        c0 = DA_MFMA(kf[4], qr[2], c0); c1 = DA_MFMA(kf[5], qr[2], c1);
        c0 = DA_MFMA(kf[6], qr[3], c0); c1 = DA_MFMA(kf[7], qr[3], c1);
        bf16x8 va[4], vb[4];
        DA_VLOAD(va, 0); DA_VLOAD(vb, 1);
        DA_SBAR();
        if (moved) {
#pragma unroll
            for (int r = 0; r < 16; ++r) { c0[r] -= mhat; c1[r] -= mhat; } }
        if (t * KVB + 63 + 113 > q0 + qblk * 32) {
            const int kb = t * KVB + 4 * hi;
#pragma unroll
            for (int r = 0; r < 16; ++r) {
                const int d0 = qpos - (kb + (r & 3) + 8 * (r >> 2)); const int d1 = d0 - 32;
                c0[r] += btab[(d0 < 127 ? d0 : 127) + 127];
                c1[r] += btab[(d1 < 127 ? d1 : 127) + 127]; } }
        {
            const float rm = rowmax(c0, c1);
            if (__any(rm > THR)) {
                const float dl = __builtin_fmaxf(rm, 0.f); mhat += dl; moved = true;
#pragma unroll
                for (int r = 0; r < 16; ++r) { c0[r] -= dl; c1[r] -= dl; }
                const float f = __builtin_amdgcn_exp2f(-dl); l_reg *= f;
                if (hi == 0) wsf[r32] = f;
                asm volatile("s_waitcnt lgkmcnt(0)" ::: "memory");
#pragma unroll
                for (int r = 0; r < 16; ++r) { const float fr = wsf[crow(r, hi)];
#pragma unroll
                    for (int g = 0; g < 4; ++g) o[g][r] *= fr; }
            }
        }
        float sacc = 0.f;
#pragma unroll
        for (int r = 0; r < 16; ++r) { c0[r] = __builtin_amdgcn_exp2f(c0[r]); c1[r] = __builtin_amdgcn_exp2f(c1[r]); sacc += c0[r] + c1[r]; }
        l_reg += sacc;
        bf16x8 pa[4];
        {
            u32x4 w0 = {cvtpk(c0[0], c0[1]), cvtpk(c0[2], c0[3]), cvtpk(c0[4], c0[5]), cvtpk(c0[6], c0[7])};
            u32x4 w1 = {cvtpk(c0[8], c0[9]), cvtpk(c0[10], c0[11]), cvtpk(c0[12], c0[13]), cvtpk(c0[14], c0[15])};
            u32x4 w2 = {cvtpk(c1[0], c1[1]), cvtpk(c1[2], c1[3]), cvtpk(c1[4], c1[5]), cvtpk(c1[6], c1[7])};
            u32x4 w3 = {cvtpk(c1[8], c1[9]), cvtpk(c1[10], c1[11]), cvtpk(c1[12], c1[13]), cvtpk(c1[14], c1[15])};
            pa[0] = __builtin_bit_cast(bf16x8, w0); pa[1] = __builtin_bit_cast(bf16x8, w1); pa[2] = __builtin_bit_cast(bf16x8, w2); pa[3] = __builtin_bit_cast(bf16x8, w3);
        }
        DA_SBAR();
        bf16x8 vc[4], vd[4];
        DA_VLOAD(vc, 2);
#pragma unroll
        for (int ks = 0; ks < 4; ++ks) o[0] = DA_MFMA(pa[ks], va[ks], o[0]);
        DA_SBAR();
        DA_VLOAD(vd, 3);
#pragma unroll
        for (int ks = 0; ks < 4; ++ks) o[1] = DA_MFMA(pa[ks], vb[ks], o[1]);
        DA_SBAR();
        DA_KLOAD(t + 1);
#pragma unroll
        for (int ks = 0; ks < 4; ++ks) o[2] = DA_MFMA(pa[ks], vc[ks], o[2]);
        DA_SBAR();
#pragma unroll
        for (int ks = 0; ks < 4; ++ks) o[3] = DA_MFMA(pa[ks], vd[ks], o[3]);
        DA_SBAR();
        if (t + 1 < NT) {
            if (t + 3 < NT) { DA_WAIT_BAR(4); } else { DA_WAIT_BAR(0); }
            if (t + 4 < NT) DA_DMA(t + 4, (t & 3) * SLOT);
        }
    }
#undef DA_VLOAD
#undef DA_KLOAD
    asm volatile("s_waitcnt vmcnt(0) lgkmcnt(0)\n\ts_barrier" ::: "memory");
    { auto rr = __builtin_amdgcn_permlane32_swap(__float_as_uint(l_reg), __float_as_uint(l_reg), false, false); l_reg = __uint_as_float(rr[0]) + __uint_as_float(rr[1]); }
    if (hi == 0) wsf[32 + r32] = l_reg;
    asm volatile("s_waitcnt lgkmcnt(0)" ::: "memory");
    float rli[16];
#pragma unroll
    for (int r = 0; r < 16; ++r) rli[r] = __builtin_amdgcn_rcpf(wsf[32 + crow(r, hi)]);
    LAS float* X = (LAS float*)(shm + LDS_X);
    if (map == 1) {
#pragma unroll
        for (int r = 0; r < 16; ++r)
#pragma unroll
            for (int g = 0; g < 4; ++g) X[(((wid - 4) * 16 + r) * 4 + g) * 64 + lane] = o[g][r] * rli[r];
    }
    asm volatile("s_waitcnt lgkmcnt(0)\n\ts_barrier" ::: "memory");
    if (map == 0) {
        float ss[16];
#pragma unroll
        for (int r = 0; r < 16; ++r) { float s = 0.f;
#pragma unroll
            for (int g = 0; g < 4; ++g) { const float d = o[g][r] * rli[r] - lam * X[((wid * 16 + r) * 4 + g) * 64 + lane]; o[g][r] = d; s += d * d; }
            ss[r] = s; }
#pragma unroll
        for (int r = 0; r < 16; ++r) { float s = ss[r];
            s += __shfl_xor(s, 1); s += __shfl_xor(s, 2); s += __shfl_xor(s, 4); s += __shfl_xor(s, 8); s += __shfl_xor(s, 16);
            ss[r] = (1.0f / sqrtf(s * (1.0f / 128.0f) + GN_EPS)) * (1.0f - LAMBDA_INIT); }
        float gsub[4];
#pragma unroll
        for (int g = 0; g < 4; ++g) gsub[g] = subln_g[32 * g + r32];
        LAS bf16* stg = (LAS bf16*)(shm + LDS_OST) + wid * 4096;
#pragma unroll
        for (int r = 0; r < 16; ++r) { const int orow = crow(r, hi);
#pragma unroll
            for (int g = 0; g < 4; ++g) stg[orow * 128 + 32 * g + r32] = (bf16)f2bf(o[g][r] * ss[r] * gsub[g]); }
        asm volatile("s_waitcnt lgkmcnt(0)" ::: "memory");
        bf16* Ow = Q + (rowbase + q0 + qblk * 32) * PITCH + h * 128;
#pragma unroll
        for (int i = 0; i < 8; ++i) { const int row = i * 4 + (lane >> 4), ch = lane & 15;
            const u32x4 v = *(const LAS u32x4*)(stg + row * 128 + ch * 8);
            if (STORE) *(u32x4*)(Ow + (long)row * PITCH + ch * 8) = v; else asm volatile("" :: "v"(v)); }
    }
    asm volatile("s_waitcnt vmcnt(0) lgkmcnt(0)\n\ts_barrier" ::: "memory");
#undef DA_DMA
}

template <bool STORE, int MODE = 0> __device__ __forceinline__ void attn_phase(LAS char* shm, bf16* Q, const bf16* K, const bf16* V, const float* lq1, const float* lk1, const float* lq2, const float* lk2,
                                           const float* subln_g, const float* rel_bias, int vcu, int G) {
    const float lam = diff_lambda(lq1, lk1, lq2, lk2);
    const int tid = threadIdx.x;
    for (int bh = vcu >> 3; bh < BATCH * AH; bh += (G >> 3)) {
        const int b = bh >> 4, h = bh & 15, s = vcu & 7;
        if (tid < 255) ((LAS float*)(shm + LDS_BT))[tid] = tid < 127 ? -INFINITY : (rel_bias[t5_bucket(tid - 127) * 16 + h] - rel_bias[31 * 16 + h]) * LOG2E;
        asm volatile("s_waitcnt lgkmcnt(0)\n\ts_barrier" ::: "memory");
#pragma unroll 1
        for (int i = 0; i < 8; ++i) {
            const int base = (i >> 1) * 16; const int qb = (i & 1) ? base + 15 - s : base + s;
            attn_unit<STORE, MODE>(b, h, qb, Q, K, V, lam, subln_g, shm);
        }
    }
}
#undef DA_SBAR
#undef DA_MFMA
#undef DA_WAIT_BAR
#undef DA_MX3
}

namespace rt {
using bf16x8 = __attribute__((ext_vector_type(8))) short;
using s16x4 = __attribute__((ext_vector_type(4))) short;
using f32x4v = __attribute__((ext_vector_type(4))) float;
using u32x4 = __attribute__((ext_vector_type(4))) unsigned;
constexpr int QS = 264, KS = 264, KT = 72, VT = 72, SS = 72;
constexpr int OFF_Q = 0, OFF_K = OFF_Q + 64 * QS * 2, OFF_KT = OFF_K + 64 * KS * 2, OFF_VT = OFF_KT + 256 * KT * 2, OFF_S = OFF_VT + 128 * VT * 2, LDS_END = OFF_S + 64 * SS * 2;
#define RT_MFMA(a, b, c) __builtin_amdgcn_mfma_f32_16x16x32_bf16(a, b, c, 0, 0, 0)

template <bool FULL, bool STORE> __device__ __forceinline__ void ret_unit(int unit, const bf16* Q, const bf16* K, bf16* V, float* E, LAS char* shm) {
    int tid_ = threadIdx.x; asm volatile("" : "+v"(tid_));
    const int tid = tid_, lane = tid & 63, c = lane & 15, g = lane >> 4; const int wid = __builtin_amdgcn_readfirstlane(tid >> 6);
    const int seg = unit & 7, dvs = (unit >> 3) & 3, bh = unit >> 5, b = bh >> 2, h = bh & 3;
    if (!FULL && seg == 7) return;
    const float lg2 = __builtin_amdgcn_logf(1.0f - __builtin_amdgcn_exp2f(-5.0f - (float)h));
    const float d64 = __builtin_amdgcn_exp2f(64.0f * lg2), d1024 = __builtin_amdgcn_exp2f(1024.0f * lg2);
    const size_t tok0 = (size_t)b * SEQ + (size_t)seg * 1024;
    const bf16* Qg = Q + tok0 * 1024 + h * 256; const bf16* Kg = K + tok0 * 1024 + h * 256;
    bf16* Vg = V + tok0 * 2048 + h * 512 + dvs * 128;
    LAS bf16* Qs = (LAS bf16*)(shm + OFF_Q); LAS bf16* Ks = (LAS bf16*)(shm + OFF_K); LAS bf16* KTs = (LAS bf16*)(shm + OFF_KT);
    LAS bf16* VTs = (LAS bf16*)(shm + OFF_VT); LAS bf16* Ss = (LAS bf16*)(shm + OFF_S);
    f32x4v R[16];
#pragma unroll
    for (int kt = 0; kt < 16; ++kt) R[kt] = (f32x4v){0.f, 0.f, 0.f, 0.f};
    if (FULL) {
        for (int j = 0; j < seg; ++j) {
            const float* Ej = E + ((size_t)(unit - seg + j) * 8 + wid) * 4096 + lane;
#pragma unroll
            for (int kt = 0; kt < 16; ++kt)
#pragma unroll
                for (int r = 0; r < 4; ++r) R[kt][r] = d1024 * R[kt][r] + Ej[(kt * 4 + r) * 64];
        }
    }
    u32x4 pq[4], pk[4], pv[2];
#define RT_LOAD(step) do { \
        if (FULL) { _Pragma("unroll") for (int it = 0; it < 4; ++it) pq[it] = *(const u32x4*)(Qg + (size_t)((step) * 64 + (tid >> 5) + 16 * it) * 1024 + (tid & 31) * 8); } \
        _Pragma("unroll") for (int it = 0; it < 4; ++it) pk[it] = *(const u32x4*)(Kg + (size_t)((step) * 64 + lane) * 1024 + (wid * 4 + it) * 8); \
        _Pragma("unroll") for (int it = 0; it < 2; ++it) pv[it] = *(const u32x4*)(Vg + (size_t)((step) * 64 + lane) * 2048 + (wid * 2 + it) * 8); } while (0)
#define RT_STORE() do { \
        if (FULL) { _Pragma("unroll") for (int it = 0; it < 4; ++it) *(LAS u32x4*)(Qs + ((tid >> 5) + 16 * it) * QS + (tid & 31) * 8) = pq[it]; \
                    _Pragma("unroll") for (int it = 0; it < 4; ++it) *(LAS u32x4*)(Ks + lane * KS + (wid * 4 + it) * 8) = pk[it]; } \
        _Pragma("unroll") for (int it = 0; it < 4; ++it) { const int d0_ = (wid * 4 + it) * 8; \
            _Pragma("unroll") for (int w_ = 0; w_ < 4; ++w_) { const unsigned x_ = pk[it][w_]; KTs[(d0_ + 2 * w_) * KT + lane] = (bf16)(x_ & 0xffffu); KTs[(d0_ + 2 * w_ + 1) * KT + lane] = (bf16)(x_ >> 16); } } \
        _Pragma("unroll") for (int it = 0; it < 2; ++it) { const int d0_ = (wid * 2 + it) * 8; \
            _Pragma("unroll") for (int w_ = 0; w_ < 4; ++w_) { const unsigned x_ = pv[it][w_]; VTs[(d0_ + 2 * w_) * VT + lane] = (bf16)(x_ & 0xffffu); VTs[(d0_ + 2 * w_ + 1) * VT + lane] = (bf16)(x_ >> 16); } } } while (0)
    RT_LOAD(0);
    RT_STORE();
#pragma unroll 1
    for (int step = 0; step < 16; ++step) {
        __syncthreads();
        if (step + 1 < 16) RT_LOAD(step + 1);
        if (FULL) {
            const int qt_s = wid >> 1;
#pragma unroll
            for (int u = 0; u < 2; ++u) {
                const int kt2 = 2 * (wid & 1) + u;
                f32x4v s = (f32x4v){0.f, 0.f, 0.f, 0.f};
                if (kt2 <= qt_s) {
#pragma unroll
                    for (int kk = 0; kk < 8; ++kk) {
                        const bf16x8 a = *(const LAS bf16x8*)(Qs + (16 * qt_s + c) * QS + kk * 32 + 8 * g);
                        const bf16x8 bb = *(const LAS bf16x8*)(Ks + (16 * kt2 + c) * KS + kk * 32 + 8 * g);
                        s = RT_MFMA(a, bb, s);
                        if (kk & 1) __builtin_amdgcn_sched_barrier(0);
                    }
                    if (kt2 == qt_s) {
#pragma unroll
                        for (int r = 0; r < 4; ++r) if (c > 4 * g + r) s[r] = 0.f;
                    }
                }
#pragma unroll
                for (int r = 0; r < 4; ++r) Ss[(16 * qt_s + 4 * g + r) * SS + 16 * kt2 + c] = (bf16)f2bf(s[r]);
            }
            f32x4v RT[4];
#pragma unroll
            for (int qt = 0; qt < 4; ++qt) RT[qt] = (f32x4v){0.f, 0.f, 0.f, 0.f};
#pragma unroll
            for (int kb = 0; kb < 8; ++kb) {
                u32x4 bw; bw.x = pg8::cvt_pk_bf16(R[2 * kb][0], R[2 * kb][1]); bw.y = pg8::cvt_pk_bf16(R[2 * kb][2], R[2 * kb][3]);
                bw.z = pg8::cvt_pk_bf16(R[2 * kb + 1][0], R[2 * kb + 1][1]); bw.w = pg8::cvt_pk_bf16(R[2 * kb + 1][2], R[2 * kb + 1][3]);
                const bf16x8 bb = __builtin_bit_cast(bf16x8, bw);
#pragma unroll
                for (int qt = 0; qt < 4; ++qt) {
                    const s16x4 lo = *(const LAS s16x4*)(Qs + (16 * qt + c) * QS + 32 * kb + 4 * g);
                    const s16x4 hh = *(const LAS s16x4*)(Qs + (16 * qt + c) * QS + 32 * kb + 16 + 4 * g);
                    const bf16x8 a = {lo[0], lo[1], lo[2], lo[3], hh[0], hh[1], hh[2], hh[3]};
                    RT[qt] = RT_MFMA(a, bb, RT[qt]);
                }
                __builtin_amdgcn_sched_barrier(0);
            }
            __syncthreads();
#pragma unroll
            for (int kk = 0; kk < 2; ++kk) {
                const bf16x8 bb = *(const LAS bf16x8*)(VTs + (16 * wid + c) * VT + kk * 32 + 8 * g);
#pragma unroll
                for (int qt = 0; qt < 4; ++qt) {
                    const bf16x8 a = *(const LAS bf16x8*)(Ss + (16 * qt + c) * SS + kk * 32 + 8 * g);
                    RT[qt] = RT_MFMA(a, bb, RT[qt]);
                }
            }
#pragma unroll
            for (int qt = 0; qt < 4; ++qt)
#pragma unroll
                for (int r = 0; r < 4; ++r) { if (STORE) Vg[(size_t)(step * 64 + 16 * qt + 4 * g + r) * 2048 + 16 * wid + c] = (bf16)f2bf(RT[qt][r]); else asm volatile("" :: "v"(RT[qt][r])); }
        }
#pragma unroll
        for (int kk = 0; kk < 2; ++kk) {
            const bf16x8 bb = *(const LAS bf16x8*)(VTs + (16 * wid + c) * VT + kk * 32 + 8 * g);
#pragma unroll
            for (int kt = 0; kt < 16; ++kt) {
                const bf16x8 a = *(const LAS bf16x8*)(KTs + (16 * kt + c) * KT + kk * 32 + 8 * g);
                R[kt] = RT_MFMA(a, bb, R[kt]);
                if ((kt & 3) == 3) __builtin_amdgcn_sched_barrier(0);
            }
        }
#pragma unroll
        for (int kt = 0; kt < 16; ++kt) R[kt] = R[kt] * d64;
        __syncthreads();
        if (step + 1 < 16) RT_STORE();
    }
    if (!FULL) {
        float* Eu = E + ((size_t)unit * 8 + wid) * 4096 + lane;
#pragma unroll
        for (int kt = 0; kt < 16; ++kt)
#pragma unroll
            for (int r = 0; r < 4; ++r) Eu[(kt * 4 + r) * 64] = R[kt][r];
    }
    __syncthreads();
#undef RT_LOAD
#undef RT_STORE
}
#undef RT_MFMA
}

constexpr int RING_OFF = 0, RING_BYTES = 143360;
constexpr int LDSCTL_OFF = RING_BYTES, MISC_OFF = LDSCTL_OFF + 320;
constexpr int LDS_BYTES = 147456;

#ifndef PROBE_ATT
#define PROBE_ATT 0
#endif
#ifndef PROBE_ATT_MODE
#define PROBE_ATT_MODE 0
#endif
#ifndef PROBE_RET
#define PROBE_RET 0
#endif
#ifndef PROBE_GEMM
#define PROBE_GEMM 0
#endif
#ifndef PROBE_MISC
#define PROBE_MISC 0
#endif
struct Frame {
    LAS unsigned char* lds;
    volatile LAS unsigned* MISC;
    gu32* ctl;
    int tid, lane, wave;
    int vcu, G;
};

struct Args { const float* in[13]; float* out; unsigned char* ws; int ph_lo, ph_hi; };

__global__ void __launch_bounds__(NTHREADS, 2) mega_fwd(Args args) {
    extern __shared__ __attribute__((aligned(16))) unsigned char lds[];
    Frame F;
    F.lds = (LAS unsigned char*)lds;
    F.MISC = (volatile LAS unsigned*)(F.lds + MISC_OFF);
    F.tid = threadIdx.x; F.lane = F.tid & 63; F.wave = __builtin_amdgcn_readfirstlane(F.tid >> 6);
    F.G = gridDim.x; { const int bx = blockIdx.x; F.vcu = (F.G % 8 == 0) ? (bx % 8) * (F.G / 8) + bx / 8 : bx; }
    unsigned char* ws = args.ws;
    F.ctl = (gu32*)(ws + WS_CTL);
    const float* x = args.in[0]; const float* pre_g = args.in[1]; const float* post_g = args.in[2];
    const float* ret_w_in = args.in[3]; const float* ret_w_out = args.in[4];
    const float* diff_w_in = args.in[5]; const float* diff_w_out = args.in[6];
    const float* lq1 = args.in[7]; const float* lk1 = args.in[8]; const float* lq2 = args.in[9]; const float* lk2 = args.in[10];
    const float* subln_g = args.in[11]; const float* rel_bias = args.in[12];
    float* out = args.out;
    bf16* W0in = (bf16*)(ws + WS_W0IN); bf16* W0out = (bf16*)(ws + WS_W0OUT); bf16* XN = (bf16*)(ws + WS_XN);
    bf16* Q0 = (bf16*)(ws + WS_Q0); bf16* K0 = (bf16*)(ws + WS_K0); bf16* V0 = (bf16*)(ws + WS_V0); bf16* G0 = (bf16*)(ws + WS_G0);
    bf16* Q1 = (bf16*)(ws + WS_Q1); bf16* K1 = (bf16*)(ws + WS_K1); bf16* V1 = (bf16*)(ws + WS_V1);
    bf16* W1g = (bf16*)(ws + WS_W1G); bf16* W1out = (bf16*)(ws + WS_W1OUT);
    float* YF0 = (float*)(ws + WS_YF_L0); float* YF1 = (float*)(ws + WS_YF_L1);

    for (int u = F.tid; u < (LDS_BYTES - LDSCTL_OFF) / 4; u += NTHREADS) ((LAS unsigned*)(F.lds + LDSCTL_OFF))[u] = 0u;
    __syncthreads();
    XcdBarrier bar = xcd_barrier_post((unsigned*)(F.ctl + CW_BAR), F.MISC + 8);
#define GRID_BAR() xcd_barrier(bar)

    const int gw = F.vcu * NWAVES + F.wave, NGW = F.G * NWAVES;
    const int gtid = F.vcu * NTHREADS + F.tid, NT = F.G * NTHREADS;
    LAS float* scr = (LAS float*)(F.lds + RING_OFF + F.wave * 16384);

    for (int rep = 0; rep < 1 + PROBE_MISC; ++rep) {
    transpose_all(ret_w_in, DM, RET_COLS, W0in, 0, RET_COLS, scr, gw, NGW, F.lane);
    transpose_all(ret_w_out, DI, DM, W0out, 0, DM, scr, gw, NGW, F.lane);
    norm_rows(x, nullptr, nullptr, pre_g, nullptr, XN, 0, gw, NGW, F.lane); }
    GRID_BAR();

    {
        pg8::Gemm g{XN, W0in, MROWS, RET_COLS, DM}; pg8::StaticOrder S; S.init(MROWS, RET_COLS, F.G, (int)blockIdx.x);
        pg8::EpiRetIn<true> E{Q0, K0, V0, G0};
        for (int rep = 0; rep < 1 + PROBE_GEMM; ++rep)
            pg8::gemm_phase<pg8::EpiRetIn<true>, pg8::StaticOrder, PG8_ALIGN, PG8_SP2>(F.lds + RING_OFF, g, S, E);
    }
    GRID_BAR();

    {
        float* Ebuf = (float*)(ws + WS_XN);
        transpose_all(diff_w_in, DM, DIFF_COLS, W0in, 0, DIFF_QKV_COLS, scr, gw, NGW, F.lane);
        transpose_all(diff_w_in, DM, DIFF_COLS, W1g, DIFF_QKV_COLS, DIFF_COLS, scr, gw, NGW, F.lane);
        transpose_all(diff_w_out, DI, DM, W1out, 0, DM, scr, gw, NGW, F.lane);
        __syncthreads();
        for (int rep = 0; rep < 1 + PROBE_RET; ++rep) for (int u = F.vcu; u < 256; u += F.G) rt::ret_unit<false, true>(u, Q0, K0, V0, Ebuf, (LAS char*)(F.lds + RING_OFF));
        GRID_BAR();
        for (int rep = 0; rep < PROBE_RET; ++rep) for (int u = F.vcu; u < 256; u += F.G) rt::ret_unit<true, false>(u, Q0, K0, V0, Ebuf, (LAS char*)(F.lds + RING_OFF));
        for (int u = F.vcu; u < 256; u += F.G) rt::ret_unit<true, true>(u, Q0, K0, V0, Ebuf, (LAS char*)(F.lds + RING_OFF));
        GRID_BAR();
        gn_gate_rows(V0, G0, gw, NGW, F.lane);
    }
    GRID_BAR();

    {
        pg8::Gemm g{G0, W0out, MROWS, DM, DI}; pg8::StaticOrder S; S.init(MROWS, DM, F.G, (int)blockIdx.x);
        pg8::EpiF32 E{YF0, DM, 0};
        for (int rep = 0; rep < 1 + PROBE_GEMM; ++rep)
            pg8::gemm_phase<pg8::EpiF32, pg8::StaticOrder, PG8_ALIGN, PG8_SP2>(F.lds + RING_OFF, g, S, E);
    }
    GRID_BAR();
    for (int rep = 0; rep < 1 + PROBE_MISC; ++rep) norm_rows(YF0, x, post_g, pre_g + DM, out, XN, 1, gw, NGW, F.lane);
    GRID_BAR();

    {
        pg8::Gemm g{XN, W0in, MROWS, DIFF_QKV_COLS, DM}; pg8::StaticOrder S; S.init(MROWS, DIFF_QKV_COLS, F.G, (int)blockIdx.x);
        pg8::EpiBf16S E{Q1, (size_t)(WS_K1 - WS_Q1) / 2, DI, DI, QSCALE2, 0};
        for (int rep = 0; rep < 1 + PROBE_GEMM; ++rep)
            pg8::gemm_phase<pg8::EpiBf16S, pg8::StaticOrder, PG8_ALIGN, PG8_SP2>(F.lds + RING_OFF, g, S, E);
    }
    GRID_BAR();

    for (int rep = 0; rep < PROBE_ATT; ++rep) da::attn_phase<false, PROBE_ATT_MODE>((LAS char*)(F.lds + RING_OFF), Q1, K1, V1, lq1, lk1, lq2, lk2, subln_g, rel_bias, F.vcu, F.G);
    da::attn_phase<true>((LAS char*)(F.lds + RING_OFF), Q1, K1, V1, lq1, lk1, lq2, lk2, subln_g, rel_bias, F.vcu, F.G);
    GRID_BAR();

    {
        pg8::Gemm g{XN, W1g, MROWS, DI, DM}; pg8::StaticOrder S; S.init(MROWS, DI, F.G, (int)blockIdx.x);
        pg8::EpiGate E{Q1, DI, 0};
        for (int rep = 0; rep < PROBE_GEMM; ++rep) { pg8::EpiGateT<false> E2{Q1, DI, 0}; pg8::gemm_phase<pg8::EpiGateT<false>, pg8::StaticOrder, PG8_ALIGN, PG8_SP2>(F.lds + RING_OFF, g, S, E2); }
        pg8::gemm_phase<pg8::EpiGate, pg8::StaticOrder, PG8_ALIGN, PG8_SP2>(F.lds + RING_OFF, g, S, E);
    }
    GRID_BAR();

    {
        pg8::Gemm g{Q1, W1out, MROWS, DM, DI}; pg8::StaticOrder S; S.init(MROWS, DM, F.G, (int)blockIdx.x);
        pg8::EpiF32 E{YF1, DM, 0};
        for (int rep = 0; rep < 1 + PROBE_GEMM; ++rep)
            pg8::gemm_phase<pg8::EpiF32, pg8::StaticOrder, PG8_ALIGN, PG8_SP2>(F.lds + RING_OFF, g, S, E);
    }
    GRID_BAR();
    norm_rows(YF1, out, post_g + DM, nullptr, out, nullptr, 2, gw, NGW, F.lane);
}

extern "C" void kernel_launch(void* const* d_in, const int* in_sizes, int n_in, void* d_out, int out_size, void* d_ws, size_t ws_size, hipStream_t stream) {
    static int grid = 0;
    if (grid == 0) {
        if (n_in != 13 || out_size != MROWS * DM || ws_size < WS_END) { fprintf(stderr, "kernel_launch: unexpected shapes (n_in %d out %d ws %zu)\n", n_in, out_size, ws_size); grid = -1; return; }
        int dev = 0, cus = 0, per_cu = 0;
        if (hipGetDevice(&dev) != hipSuccess || hipDeviceGetAttribute(&cus, hipDeviceAttributeMultiprocessorCount, dev) != hipSuccess) { grid = -1; return; }
        if (hipFuncSetAttribute((const void*)mega_fwd, hipFuncAttributeMaxDynamicSharedMemorySize, LDS_BYTES) != hipSuccess) { fprintf(stderr, "kernel_launch: hipFuncSetAttribute failed\n"); grid = -1; return; }
        if (hipOccupancyMaxActiveBlocksPerMultiprocessor(&per_cu, (const void*)mega_fwd, NTHREADS, LDS_BYTES) != hipSuccess || per_cu < 1)
            fprintf(stderr, "kernel_launch: occupancy query reports %d workgroups per CU\n", per_cu);
        (void)hipGetLastError();
        grid = cus;
        if (grid != 256) fprintf(stderr, "kernel_launch: %d CUs (built for 256)\n", grid);
    }
    if (grid < 0) return;
    if (hipMemsetAsync((char*)d_ws + WS_CTL, 0, CTL_ZERO_BYTES, stream) != hipSuccess) { fprintf(stderr, "kernel_launch: memset failed\n"); return; }
    Args a; memset(&a, 0, sizeof(a));
    for (int i = 0; i < 13; ++i) a.in[i] = (const float*)d_in[i];
    a.out = (float*)d_out; a.ws = (unsigned char*)d_ws; a.ph_lo = 0; a.ph_hi = 100;
    hipLaunchKernelGGL(mega_fwd, dim3(grid), dim3(NTHREADS), LDS_BYTES, stream, a);
}
```

```cpp
#include <hip/hip_runtime.h>
#include <cstdio>
#include <cstdint>
#include <cstring>
#include <cmath>
namespace pg8 {
#define PG8_LAS __attribute__((address_space(3)))
typedef unsigned short bf16_t;
typedef short bf16x8 __attribute__((ext_vector_type(8)));
typedef float f32x4 __attribute__((ext_vector_type(4)));
typedef unsigned u32x4 __attribute__((ext_vector_type(4)));
constexpr int BM = 256, BK = 64, HALF = 128, HTB = HALF * BK * 2  , STAGE_BYTES = 8 * HTB, NXCD = 8, WGM = 8;

__host__ __device__ __forceinline__ int lds_byte(int r, int c) { const int st = (r >> 4) * 2 + (c >> 5), rr = r & 15, cc = c & 31, ob = rr * 64 + cc * 2; return st * 1024 + (ob ^ (((ob >> 9) & 1) << 5)); }
__host__ __device__ __forceinline__ void stage_rc(int b, int& R, int& C) { const int st = b / 1024, sb = b % 1024, swz = sb ^ (((sb >> 9) & 1) << 5); R = (st >> 1) * 16 + swz / 64; C = (st & 1) * 32 + (swz % 64) / 2; }
__host__ __device__ __forceinline__ int perm32(int rho) { const int n = rho >> 4, i = rho & 15; return 8 * (i >> 2) + 4 * n + (i & 3); }

struct Unit { int pm, pn; };
struct Gemm { const bf16_t* A; const bf16_t* Bt; int M, N, K; };

struct StaticOrder {
    int nM, nN, nwg, G, c;
    __host__ __device__ void init(int M, int N, int G_, int c_) { nM = M / BM; nN = N / BM; nwg = nM * nN; G = G_; c = c_; }
    __host__ __device__ bool next(int i, Unit& u) const {
        const long L = (long)i * G + c; if (L >= nwg) return false;
        int wgid = (int)L; { const int q = nwg / NXCD, r = nwg % NXCD, xcd = wgid % NXCD, off = wgid / NXCD; wgid = (xcd < r ? xcd * (q + 1) : r * (q + 1) + (xcd - r) * q) + off; }
        const int nig = WGM * nN, gid = wgid / nig, fm = gid * WGM, gsz = (nM - fm) < WGM ? (nM - fm) : WGM;
        u.pm = fm + ((wgid % nig) % gsz); u.pn = (wgid % nig) / gsz; return true;
    }
    __device__ __forceinline__ void a_ready(const Unit&) const {}
    __device__ __forceinline__ void done(const Unit&) const {}
};


__device__ __forceinline__ unsigned cvt_pk_bf16(float lo, float hi) { unsigned r; asm volatile("v_cvt_pk_bf16_f32 %0, %1, %2" : "=v"(r) : "v"(lo), "v"(hi)); return r; }
__device__ __forceinline__ float silu_f(float x) { return x * __builtin_amdgcn_rcpf(1.0f + __builtin_amdgcn_exp2f(-1.4426950408889634f * x)); }
__device__ __forceinline__ float bf_lo(unsigned w) { return __uint_as_float(w << 16); }
__device__ __forceinline__ float bf_hi(unsigned w) { return __uint_as_float(w & 0xffff0000u); }

struct EpiBf16S {
    static constexpr bool PERM = true, AFTER_DRAIN = false;
    bf16_t* O; size_t split_stride; int ldc; int split_cols; float scale0; int pad;
    __device__ __forceinline__ void operator()(const f32x4 (&acc)[2][2][4][2], const Unit& u, int wr, int wc, int fr, int fq) const {
        const int row0 = u.pm * BM + wr * 64 + fr; int colt = u.pn * BM; bf16_t* base = O;
        float sc = 1.f; if (split_cols) { const int t = colt / split_cols; base += (size_t)t * split_stride; colt -= t * split_cols; if (t == 0) sc = scale0; }
        const int col0 = colt + wc * 32 + 8 * fq;
#pragma unroll
        for (int ai = 0; ai < 2; ++ai)
#pragma unroll
            for (int m = 0; m < 4; ++m) { bf16_t* rowp = base + (size_t)(row0 + ai * HALF + m * 16) * ldc + col0;
#pragma unroll
                for (int bj = 0; bj < 2; ++bj) { f32x4 v0 = acc[ai][bj][m][0] * sc, v1 = acc[ai][bj][m][1] * sc;
                    u32x4 w; w.x = cvt_pk_bf16(v0[0], v0[1]); w.y = cvt_pk_bf16(v0[2], v0[3]); w.z = cvt_pk_bf16(v1[0], v1[1]); w.w = cvt_pk_bf16(v1[2], v1[3]);
                    *(u32x4*)(rowp + bj * HALF) = w; } }
    }
};

struct EpiF32 {
    static constexpr bool PERM = false, AFTER_DRAIN = false;
    float* O; int ldc; int pad;
    __device__ __forceinline__ void operator()(const f32x4 (&acc)[2][2][4][2], const Unit& u, int wr, int wc, int fr, int fq) const {
        const int row0 = u.pm * BM + wr * 64 + fr; const int col0 = u.pn * BM + wc * 32 + 4 * fq;
#pragma unroll
        for (int ai = 0; ai < 2; ++ai)
#pragma unroll
            for (int m = 0; m < 4; ++m) { float* rowp = O + (size_t)(row0 + ai * HALF + m * 16) * ldc + col0;
#pragma unroll
                for (int bj = 0; bj < 2; ++bj)
#pragma unroll
                    for (int n = 0; n < 2; ++n) *(f32x4*)(rowp + bj * HALF + n * 16) = acc[ai][bj][m][n]; }
    }
};

template <bool FOLD> struct EpiRetIn {
    static constexpr bool PERM = true, AFTER_DRAIN = false;
    bf16_t *Q, *K, *V, *G;
    __device__ __forceinline__ void operator()(const f32x4 (&acc)[2][2][4][2], const Unit& u, int wr, int wc, int fr, int fq) const {
        const int row0 = u.pm * BM + wr * 64 + fr; const int c8 = wc * 32 + 8 * fq; const int pn = u.pn;
        if (pn < 8) {
            const bool isq = pn < 4; const int head = pn & 3;
            bf16_t* base = (isq ? Q : K) + head * 256 + c8;
            float wv[8];
#pragma unroll
            for (int j = 0; j < 8; ++j) wv[j] = __builtin_amdgcn_exp2f(-(float)(c8 + j) * (13.287712379549449f / 128.0f)) * 0.15915494309189535f;
            const float lg2 = __log2f(1.0f - __builtin_amdgcn_exp2f(-5.0f - (float)head));
#pragma unroll
            for (int ai = 0; ai < 2; ++ai)
#pragma unroll
                for (int m = 0; m < 4; ++m) {
                    const int row = row0 + ai * HALF + m * 16; const int t = row & 8191; const float pos = (float)t;
                    float sc = isq ? 1.0f : 0.0625f;
                    if (FOLD) { const float e = (float)((t & 63) + 1) * lg2; sc *= __builtin_amdgcn_exp2f(isq ? e : -e); }
                    float o1[8], o2[8];
#pragma unroll
                    for (int n = 0; n < 2; ++n)
#pragma unroll
                        for (int i = 0; i < 4; ++i) { const int j = 4 * n + i;
                            float rev = pos * wv[j]; rev = __builtin_amdgcn_fractf(rev);
                            const float cs = __builtin_amdgcn_cosf(rev), sn = __builtin_amdgcn_sinf(rev);
                            const float x1 = acc[ai][0][m][n][i], x2 = acc[ai][1][m][n][i];
                            o1[j] = (x1 * cs - x2 * sn) * sc; o2[j] = (x1 * sn + x2 * cs) * sc; }
                    u32x4 w1, w2;
                    w1.x = cvt_pk_bf16(o1[0], o1[1]); w1.y = cvt_pk_bf16(o1[2], o1[3]); w1.z = cvt_pk_bf16(o1[4], o1[5]); w1.w = cvt_pk_bf16(o1[6], o1[7]);
                    w2.x = cvt_pk_bf16(o2[0], o2[1]); w2.y = cvt_pk_bf16(o2[2], o2[3]); w2.z = cvt_pk_bf16(o2[4], o2[5]); w2.w = cvt_pk_bf16(o2[6], o2[7]);
                    bf16_t* rp = base + (size_t)row * 1024;
                    *(u32x4*)(rp) = w1; *(u32x4*)(rp + HALF) = w2;
                }
        } else {
            const bool isv = pn < 16; const int colt = (isv ? pn - 8 : pn - 16) * BM;
            bf16_t* base = (isv ? V : G) + colt + c8;
#pragma unroll
            for (int ai = 0; ai < 2; ++ai)
#pragma unroll
                for (int m = 0; m < 4; ++m) { bf16_t* rowp = base + (size_t)(row0 + ai * HALF + m * 16) * 2048;
#pragma unroll
                    for (int bj = 0; bj < 2; ++bj) { f32x4 v0 = acc[ai][bj][m][0], v1 = acc[ai][bj][m][1];
                        if (!isv) {
#pragma unroll
                            for (int i = 0; i < 4; ++i) { v0[i] = silu_f(v0[i]); v1[i] = silu_f(v1[i]); } }
                        u32x4 w; w.x = cvt_pk_bf16(v0[0], v0[1]); w.y = cvt_pk_bf16(v0[2], v0[3]); w.z = cvt_pk_bf16(v1[0], v1[1]); w.w = cvt_pk_bf16(v1[2], v1[3]);
                        *(u32x4*)(rowp + bj * HALF) = w; } }
        }
    }
};

template <bool STORE> struct EpiGateT {
    static constexpr bool PERM = true, AFTER_DRAIN = false;
    bf16_t* O; int ldc; int pad;
    __device__ __forceinline__ void operator()(const f32x4 (&acc)[2][2][4][2], const Unit& u, int wr, int wc, int fr, int fq) const {
        const int row0 = u.pm * BM + wr * 64 + fr; const int col0 = u.pn * BM + wc * 32 + 8 * fq;
#pragma unroll
        for (int ai = 0; ai < 2; ++ai)
#pragma unroll
            for (int m = 0; m < 4; ++m) { bf16_t* rowp = O + (size_t)(row0 + ai * HALF + m * 16) * ldc + col0;
#pragma unroll
                for (int bj = 0; bj < 2; ++bj) { const f32x4 v0 = acc[ai][bj][m][0], v1 = acc[ai][bj][m][1];
                    const u32x4 ov = *(const u32x4*)(rowp + bj * HALF);
                    u32x4 w;
                    w.x = cvt_pk_bf16(silu_f(v0[0]) * bf_lo(ov.x), silu_f(v0[1]) * bf_hi(ov.x));
                    w.y = cvt_pk_bf16(silu_f(v0[2]) * bf_lo(ov.y), silu_f(v0[3]) * bf_hi(ov.y));
                    w.z = cvt_pk_bf16(silu_f(v1[0]) * bf_lo(ov.z), silu_f(v1[1]) * bf_hi(ov.z));
                    w.w = cvt_pk_bf16(silu_f(v1[2]) * bf_lo(ov.w), silu_f(v1[3]) * bf_hi(ov.w));
                    if (STORE) *(u32x4*)(rowp + bj * HALF) = w; else asm volatile("" :: "v"(w)); } }
    }
};

typedef EpiGateT<true> EpiGate;
template <class Epi, class Sched, bool ALIGN_EPI = false, bool SP2 = false>
__device__ __forceinline__ void gemm_phase(PG8_LAS unsigned char* lds, const Gemm g, const Sched& S, const Epi& E) {
    int tid_ = threadIdx.x; asm volatile("" : "+v"(tid_));
    const int tid = tid_, wid = __builtin_amdgcn_readfirstlane(tid >> 6), lane = tid & 63, wr = wid >> 2, wc = wid & 3, fr = lane & 15, fq = lane >> 4;
    const int K = g.K, nt = K / BK;
    unsigned voffA[2], voffB[2];
#pragma unroll
    for (int i = 0; i < 2; ++i) { int R, C; stage_rc(tid * 16 + i * 8192, R, C); const int Rb = Epi::PERM ? ((R & ~31) + perm32(R & 31)) : R;
        voffA[i] = (unsigned)(R * K + C) * 2u; voffB[i] = (unsigned)(Rb * K + C) * 2u; }
    const size_t kstep = (size_t)(BK * 2);
    const size_t hstep = (size_t)HALF * K * 2;
    const size_t tstep = 2 * hstep;
    const unsigned ldsw = (unsigned)wid * 1024u;
    const int aoff = lds_byte(wr * 64 + fr, fq * 8), boff = lds_byte(wc * 32 + fr, fq * 8);
#define PG8_SA(b, h) (((b) * 2 + (h)) * HTB)
#define PG8_SB(b, h) ((4 + (b) * 2 + (h)) * HTB)
#define PG8_STAGE(bufoff, gbase, voff) do { _Pragma("unroll") for (int _i = 0; _i < 2; ++_i) \
        __builtin_amdgcn_global_load_lds((const unsigned*)((const char*)(gbase) + (voff)[_i]), (PG8_LAS unsigned*)(lds + (bufoff) + ldsw + _i * 8192), 16, 0, 0); } while (0)
#define PG8_LDA(dst, b, h) do { _Pragma("unroll") for (int m = 0; m < 4; ++m) _Pragma("unroll") for (int k = 0; k < 2; ++k) dst[m][k] = *(const PG8_LAS bf16x8*)(lds + PG8_SA(b, h) + aoff + m * 2048 + k * 1024); } while (0)
#define PG8_LDB(dst, b, h) do { _Pragma("unroll") for (int n = 0; n < 2; ++n) _Pragma("unroll") for (int k = 0; k < 2; ++k) dst[n][k] = *(const PG8_LAS bf16x8*)(lds + PG8_SB(b, h) + boff + n * 2048 + k * 1024); } while (0)
#define PG8_MMA(ai, bj, At, Bt) do { __builtin_amdgcn_s_setprio(1); _Pragma("unroll") for (int m = 0; m < 4; ++m) _Pragma("unroll") for (int n = 0; n < 2; ++n) _Pragma("unroll") for (int k = 0; k < 2; ++k) \
        acc[ai][bj][m][n] = __builtin_amdgcn_mfma_f32_16x16x32_bf16(Bt[n][k], At[m][k], acc[ai][bj][m][n], 0, 0, 0); __builtin_amdgcn_s_setprio(0); } while (0)
#define PG8_WAIT_V(n) asm volatile("s_waitcnt vmcnt(" #n ")" ::: "memory")
#define PG8_WAIT_L(n) asm volatile("s_waitcnt lgkmcnt(" #n ")" ::: "memory")
#define PG8_BAR __builtin_amdgcn_s_barrier()
#define PG8_SCHED __builtin_amdgcn_sched_barrier(0)
    Unit cur, nxt; int ui = 0;
    if (!S.next(0, cur)) return;
    f32x4 acc[2][2][4][2];
#pragma unroll
    for (int a = 0; a < 2; ++a)
#pragma unroll
        for (int b = 0; b < 2; ++b)
#pragma unroll
            for (int m = 0; m < 4; ++m)
#pragma unroll
                for (int n = 0; n < 2; ++n) acc[a][b][m][n] = (f32x4){0.f, 0.f, 0.f, 0.f};
    bf16x8 At[4][2], B0[2][2], B1[2][2];
    const char* cA = (const char*)g.A + (size_t)cur.pm * tstep; const char* cB = (const char*)g.Bt + (size_t)cur.pn * tstep;
    S.a_ready(cur);
    if constexpr (SP2) {
        PG8_STAGE(PG8_SB(0, 0), cB, voffB); PG8_STAGE(PG8_SB(0, 1), cB + hstep, voffB); PG8_STAGE(PG8_SA(0, 0), cA, voffA); PG8_STAGE(PG8_SA(0, 1), cA + hstep, voffA);
        if (wr == 1) PG8_BAR;
        PG8_WAIT_V(2); PG8_BAR;
        PG8_STAGE(PG8_SB(1, 0), cB + kstep, voffB); PG8_STAGE(PG8_SA(1, 0), cA + kstep, voffA); PG8_STAGE(PG8_SB(1, 1), cB + hstep + kstep, voffB);
        PG8_WAIT_V(6); PG8_BAR;
    } else {
        PG8_STAGE(PG8_SB(0, 0), cB, voffB); PG8_STAGE(PG8_SA(0, 0), cA, voffA); PG8_STAGE(PG8_SB(0, 1), cB + hstep, voffB); PG8_STAGE(PG8_SA(0, 1), cA + hstep, voffA);
        if (wr == 1) PG8_BAR;
        PG8_WAIT_V(4); PG8_BAR;
        PG8_STAGE(PG8_SB(1, 0), cB + kstep, voffB); PG8_STAGE(PG8_SA(1, 0), cA + kstep, voffA); PG8_STAGE(PG8_SB(1, 1), cB + hstep + kstep, voffB);
        PG8_WAIT_V(6); PG8_BAR;
    }
    for (;;) {
        const bool has_next = S.next(ui + 1, nxt);
        const char* nA = has_next ? (const char*)g.A + (size_t)nxt.pm * tstep : cA; const char* nB = has_next ? (const char*)g.Bt + (size_t)nxt.pn * tstep : cB;
        for (int t = 0; t < nt; t += 2) {
            const bool last = (t == nt - 2);
            const char* a1 = cA + (size_t)(t + 1) * kstep;
            const char* a2 = last ? nA : cA + (size_t)(t + 2) * kstep; const char* b2 = last ? nB : cB + (size_t)(t + 2) * kstep;
            const char* a3 = a2 + kstep; const char* b3 = b2 + kstep;
            if (last && has_next) S.a_ready(nxt);
            if constexpr (SP2) {
            PG8_LDB(B0, 0, 0); PG8_LDB(B1, 0, 1); PG8_SCHED; PG8_LDA(At, 0, 0); PG8_STAGE(PG8_SA(1, 1), a1 + hstep, voffA);
            PG8_WAIT_V(8); PG8_WAIT_L(0); PG8_BAR; PG8_MMA(0, 0, At, B0); PG8_MMA(0, 1, At, B1); PG8_BAR; PG8_SCHED;
            PG8_LDA(At, 0, 1); PG8_STAGE(PG8_SB(0, 0), b2, voffB); PG8_STAGE(PG8_SB(0, 1), b2 + hstep, voffB); PG8_STAGE(PG8_SA(0, 0), a2, voffA);
            PG8_WAIT_V(8); PG8_WAIT_L(0); PG8_BAR; PG8_MMA(1, 0, At, B0); PG8_MMA(1, 1, At, B1); PG8_BAR; PG8_SCHED;
            PG8_LDB(B0, 1, 0); PG8_LDB(B1, 1, 1); PG8_SCHED; PG8_LDA(At, 1, 0); PG8_STAGE(PG8_SA(0, 1), a2 + hstep, voffA);
            PG8_WAIT_V(8); PG8_WAIT_L(0); PG8_BAR; PG8_MMA(0, 0, At, B0); PG8_MMA(0, 1, At, B1); PG8_BAR; PG8_SCHED;
            PG8_LDA(At, 1, 1); PG8_STAGE(PG8_SB(1, 0), b3, voffB); PG8_STAGE(PG8_SB(1, 1), b3 + hstep, voffB); PG8_STAGE(PG8_SA(1, 0), a3, voffA);
            PG8_WAIT_V(8); PG8_WAIT_L(0); PG8_BAR; PG8_MMA(1, 0, At, B0); PG8_MMA(1, 1, At, B1); PG8_BAR; PG8_SCHED;
            } else {
            PG8_LDB(B0, 0, 0); PG8_SCHED; PG8_LDA(At, 0, 0); PG8_STAGE(PG8_SA(1, 1), a1 + hstep, voffA);
            PG8_WAIT_L(8); PG8_BAR; PG8_WAIT_L(0); PG8_MMA(0, 0, At, B0); PG8_BAR; PG8_SCHED;
            PG8_LDB(B1, 0, 1); PG8_STAGE(PG8_SB(0, 0), b2, voffB);
            PG8_BAR; PG8_WAIT_L(0); PG8_MMA(0, 1, At, B1); PG8_BAR;
            PG8_LDA(At, 0, 1); PG8_STAGE(PG8_SA(0, 0), a2, voffA);
            PG8_BAR; PG8_WAIT_L(0); PG8_MMA(1, 0, At, B0); PG8_BAR; PG8_SCHED;
            PG8_STAGE(PG8_SB(0, 1), b2 + hstep, voffB);
            PG8_WAIT_V(6); PG8_BAR; PG8_MMA(1, 1, At, B1); PG8_BAR;
            PG8_LDB(B0, 1, 0); PG8_SCHED; PG8_LDA(At, 1, 0); PG8_STAGE(PG8_SA(0, 1), a2 + hstep, voffA);
            PG8_WAIT_L(8); PG8_BAR; PG8_WAIT_L(0); PG8_MMA(0, 0, At, B0); PG8_BAR; PG8_SCHED;
            PG8_LDB(B1, 1, 1); PG8_STAGE(PG8_SB(1, 0), b3, voffB);
            PG8_BAR; PG8_WAIT_L(0); PG8_MMA(0, 1, At, B1); PG8_BAR;
            PG8_LDA(At, 1, 1); PG8_STAGE(PG8_SA(1, 0), a3, voffA);
            PG8_BAR; PG8_WAIT_L(0); PG8_MMA(1, 0, At, B0); PG8_BAR; PG8_SCHED;
            PG8_STAGE(PG8_SB(1, 1), b3 + hstep, voffB);
            PG8_WAIT_V(6); PG8_BAR; PG8_MMA(1, 1, At, B1); PG8_BAR;
            }
        }
        if constexpr (ALIGN_EPI) { if (wr == 0) PG8_BAR; }
        if constexpr (!Epi::AFTER_DRAIN) { E(acc, cur, wr, wc, fr, fq); S.done(cur); }
        if (!has_next) break;
#pragma unroll
        for (int a = 0; a < 2; ++a)
#pragma unroll
            for (int b = 0; b < 2; ++b)
#pragma unroll
                for (int m = 0; m < 4; ++m)
#pragma unroll
                    for (int n = 0; n < 2; ++n) acc[a][b][m][n] = (f32x4){0.f, 0.f, 0.f, 0.f};
        cur = nxt; cA = nA; cB = nB; ++ui;
        if constexpr (ALIGN_EPI) { if (wr == 1) PG8_BAR; }
    }
    PG8_WAIT_V(0);
    if constexpr (!ALIGN_EPI) { if (wr == 0) PG8_BAR; }
    PG8_BAR;
    if constexpr (Epi::AFTER_DRAIN) { E.fused(acc, cur, wr, wc, fr, fq, lds, wid, lane); S.done(cur); }
#undef PG8_SA
#undef PG8_SB
#undef PG8_STAGE
#undef PG8_LDA
#undef PG8_LDB
#undef PG8_MMA
#undef PG8_WAIT_V
#undef PG8_WAIT_L
#undef PG8_BAR
#undef PG8_SCHED
}
}

#define PG8_SP2 true
#define PG8_ALIGN true

constexpr int BATCH = 2, SEQ = 8192, DM = 1024, DI = 2048, MROWS = BATCH * SEQ;
constexpr int RH = 4, RDK = 256, RDV = 512, RCH = 128;
constexpr int RET_COLS = 6144;
constexpr int AH = 16, AD = 64, ADV = 128;
constexpr int DIFF_QKV_COLS = 6144, DIFF_COLS = 8192;
constexpr float RMS_EPS = 1e-6f, GN_EPS = 1e-5f;
constexpr float LOG2E = 1.4426950408889634f;
constexpr float LAMBDA_INIT = 0.35550906759096926f;
constexpr float QSCALE2 = 0.125f * LOG2E;
constexpr int NWAVES = 8, NTHREADS = 512;

constexpr size_t MiB = 1u << 20;
constexpr size_t WS_CTL = 0, CTL_ZERO_BYTES = 1 * MiB;
constexpr size_t WS_XCH = 2 * MiB;
constexpr size_t WS_W0IN = 4 * MiB;
constexpr size_t WS_W0OUT = 16 * MiB;
constexpr size_t WS_XN = 20 * MiB;
constexpr size_t WS_Q0 = 52 * MiB, WS_K0 = 84 * MiB, WS_V0 = 116 * MiB, WS_G0 = 180 * MiB;
constexpr size_t WS_Q1 = 52 * MiB, WS_K1 = 116 * MiB, WS_V1 = 180 * MiB;
constexpr size_t WS_YF_L0 = 52 * MiB;
constexpr size_t WS_YF_L1 = 116 * MiB;
constexpr size_t WS_W1G = 244 * MiB;
constexpr size_t WS_W1OUT = 248 * MiB;
constexpr size_t WS_END = 256 * MiB;
constexpr int CW_TMO = 0, CW_CODE = 1;
constexpr int CW_BAR = 4096;
constexpr int CW_SEAM = 16384, SEAM_BANK = 128 * 64;

typedef unsigned short bf16;
typedef unsigned v4u __attribute__((ext_vector_type(4)));
typedef float f32x4 __attribute__((ext_vector_type(4)));
#define GAS __attribute__((address_space(1)))
#define LAS __attribute__((address_space(3)))
typedef GAS unsigned gu32;
typedef GAS unsigned long long gu64;
#define RLX_AGENT __ATOMIC_RELAXED, __HIP_MEMORY_SCOPE_AGENT
#define LDS_WAIT() asm volatile("s_waitcnt lgkmcnt(0)" ::: "memory")
#define VM_WAIT() asm volatile("s_waitcnt vmcnt(0)" ::: "memory")

__device__ __forceinline__ unsigned f2bf(float f) { unsigned u = __builtin_bit_cast(unsigned, f); return (u + 0x7fffu + ((u >> 16) & 1u)) >> 16; }
__device__ __forceinline__ unsigned pk2(float lo, float hi) { return f2bf(lo) | (f2bf(hi) << 16); }
__device__ __forceinline__ float bf2f(bf16 h) { return __uint_as_float((unsigned)h << 16); }
using pg8::bf_lo; using pg8::bf_hi;
__device__ __forceinline__ float wave_sum(float v) {
#pragma unroll
    for (int o = 1; o < 64; o <<= 1) v += __shfl_xor(v, o);
    return v;
}

__device__ __forceinline__ void transpose_item(const float* W, int K, int N, bf16* WT, int n_lo, LAS float* scr, int item, int lane) {
    const int nblk = N / 32, kb = item / nblk, nb = item % nblk, k0 = 64 * kb, n0 = 32 * nb;
#pragma unroll 8
    for (int i = 0; i < 32; ++i) { const int kk = 2 * i + (lane >> 5); scr[kk * 33 + (lane & 31)] = W[(size_t)(k0 + kk) * N + n0 + (lane & 31)]; }
    LDS_WAIT(); asm volatile("" ::: "memory");
    const int c = lane & 7;
#pragma unroll
    for (int j = 0; j < 4; ++j) { const int n = (lane >> 3) + 8 * j; const LAS float* s = scr + (8 * c) * 33 + n;
        v4u o; o.x = pk2(s[0 * 33], s[1 * 33]); o.y = pk2(s[2 * 33], s[3 * 33]); o.z = pk2(s[4 * 33], s[5 * 33]); o.w = pk2(s[6 * 33], s[7 * 33]);
        *(v4u*)(WT + (size_t)(n0 + n - n_lo) * K + k0 + 8 * c) = o; }
    LDS_WAIT(); asm volatile("" ::: "memory");
}
__device__ __forceinline__ void transpose_all(const float* W, int K, int N, bf16* WT, int n_lo, int n_hi, LAS float* scr, int gw, int NGW, int lane) {
    const int nblk = N / 32, nsel = (n_hi - n_lo) / 32, nitems = (K / 64) * nsel;
    for (int it = gw; it < nitems; it += NGW) {
        const int kb = it / nsel, nb = it % nsel + n_lo / 32;
        transpose_item(W, K, N, WT, n_lo, scr, kb * nblk + nb, lane);
    }
}

__device__ __forceinline__ void norm_rows(const float* y, const float* base, const float* gpost, const float* gpre, float* out, bf16* xn, int mode, int gw, int NGW, int lane) {
    for (int m = gw; m < MROWS; m += NGW) {
        const f32x4* yr = (const f32x4*)(y + (size_t)m * DM) + lane;
        f32x4 v[4]; float s = 0.f;
#pragma unroll
        for (int j = 0; j < 4; ++j) { v[j] = yr[64 * j]; s += (v[j].x * v[j].x + v[j].y * v[j].y) + (v[j].z * v[j].z + v[j].w * v[j].w); }
        const float rstd = 1.0f / sqrtf(wave_sum(s) * (1.0f / DM) + RMS_EPS);
        if (mode == 0) {
            unsigned long long* o8 = (unsigned long long*)(xn + (size_t)m * DM) + lane;
#pragma unroll
            for (int j = 0; j < 4; ++j) { const f32x4 g = ((const f32x4*)gpre)[64 * j + lane];
                o8[64 * j] = (unsigned long long)pk2(v[j].x * rstd * g.x, v[j].y * rstd * g.y) | ((unsigned long long)pk2(v[j].z * rstd * g.z, v[j].w * rstd * g.w) << 32); }
        } else {
            const f32x4* br = (const f32x4*)(base + (size_t)m * DM) + lane; f32x4* orow = (f32x4*)(out + (size_t)m * DM) + lane;
            float s2 = 0.f;
#pragma unroll
            for (int j = 0; j < 4; ++j) { const f32x4 g = ((const f32x4*)gpost)[64 * j + lane]; const f32x4 b = br[64 * j];
                v[j] = b + v[j] * rstd * g; orow[64 * j] = v[j];
                s2 += (v[j].x * v[j].x + v[j].y * v[j].y) + (v[j].z * v[j].z + v[j].w * v[j].w); }
            if (mode == 1) {
                const float r2 = 1.0f / sqrtf(wave_sum(s2) * (1.0f / DM) + RMS_EPS);
                unsigned long long* o8 = (unsigned long long*)(xn + (size_t)m * DM) + lane;
#pragma unroll
                for (int j = 0; j < 4; ++j) { const f32x4 g = ((const f32x4*)gpre)[64 * j + lane];
                    o8[64 * j] = (unsigned long long)pk2(v[j].x * r2 * g.x, v[j].y * r2 * g.y) | ((unsigned long long)pk2(v[j].z * r2 * g.z, v[j].w * r2 * g.w) << 32); }
            }
        }
    }
}

__device__ __forceinline__ void gn_gate_rows(const bf16* RET, bf16* G, int gw, int NGW, int lane) {
    for (int it = gw; it < MROWS * RH; it += NGW) {
        const size_t off = (size_t)it * RDV + lane * 8;
        const v4u rv = *(const v4u*)(RET + off); const v4u gv = *(const v4u*)(G + off);
        float x[8] = {bf_lo(rv.x), bf_hi(rv.x), bf_lo(rv.y), bf_hi(rv.y), bf_lo(rv.z), bf_hi(rv.z), bf_lo(rv.w), bf_hi(rv.w)};
        float g[8] = {bf_lo(gv.x), bf_hi(gv.x), bf_lo(gv.y), bf_hi(gv.y), bf_lo(gv.z), bf_hi(gv.z), bf_lo(gv.w), bf_hi(gv.w)};
        float s = 0.f;
#pragma unroll
        for (int j = 0; j < 8; ++j) s += x[j];
        const float mu = wave_sum(s) * (1.0f / RDV);
        float q = 0.f;
#pragma unroll
        for (int j = 0; j < 8; ++j) { x[j] -= mu; q += x[j] * x[j]; }
        const float rstd = 1.0f / sqrtf(wave_sum(q) * (1.0f / RDV) + GN_EPS);
        v4u o; o.x = pk2(x[0] * rstd * g[0], x[1] * rstd * g[1]); o.y = pk2(x[2] * rstd * g[2], x[3] * rstd * g[3]);
        o.z = pk2(x[4] * rstd * g[4], x[5] * rstd * g[5]); o.w = pk2(x[6] * rstd * g[6], x[7] * rstd * g[7]);
        *(v4u*)(G + off) = o;
    }
}
__device__ __forceinline__ int t5_bucket(int n) {
    if (n < 16) return n;
    int l = 16 + (int)(logf((float)n / 16.0f) / 2.0794415416798357f * 16.0f);
    return l < 31 ? l : 31;
}
__device__ __forceinline__ float ret_lg(int h) { return log1pf(-exp2f(-5.0f - (float)h)); }
#define XB_TMO      128
#define XB_XCNT(j)  (256  + 64 * (j))
#define XB_XSUB(j)  (1280 + 64 * (j))
#define XB_XGEN(j)  (2304 + 64 * (j))
#define XB_TOP      3328
#define XB_TOPGEN   3392
#define XCD_BAR_WORDS 3456
#define XB_SPIN_CAP (1u << 26)

__device__ __forceinline__ unsigned xb_ld(unsigned* p)              { return __hip_atomic_load(p, __ATOMIC_RELAXED, __HIP_MEMORY_SCOPE_AGENT); }
__device__ __forceinline__ unsigned xb_add(unsigned* p, unsigned v) { return __hip_atomic_fetch_add(p, v, __ATOMIC_RELAXED, __HIP_MEMORY_SCOPE_AGENT); }
__device__ __forceinline__ unsigned xb_xcc_id() { return (unsigned)__builtin_amdgcn_s_getreg((3 << 11) | 20) & 0xFu; }
#define XB_SPIN(cond, bar) do { unsigned _sp = 0; while (cond) { __builtin_amdgcn_s_sleep(1); \
    if ((++_sp & 255u) == 0u) { if (xb_ld(&(bar)[XB_TMO])) break; if (_sp > XB_SPIN_CAP) { atomicAdd(&(bar)[XB_TMO], 1u); break; } } } } while (0)

struct XcdBarrier {
    unsigned* bar; unsigned x;
    volatile LAS unsigned* st;
};

__device__ __forceinline__ XcdBarrier xcd_barrier_post(unsigned* bar, volatile LAS unsigned* st) {
    XcdBarrier b; b.bar = bar; b.x = xb_xcc_id(); b.st = st;
    if (threadIdx.x == 0) (void)xb_add(&bar[XB_XCNT(b.x)], 1u);
    return b;
}
__device__ __forceinline__ void xcd_barrier_complete(unsigned* bar, unsigned x, unsigned& nloc, unsigned& nx) {
    const unsigned G = gridDim.x * gridDim.y * gridDim.z;
    unsigned sum, cnt, mine, sp = 0u;
    for (;;) {
        sum = 0u; cnt = 0u; mine = 0u;
#pragma unroll
        for (unsigned j = 0; j < 16; ++j) { const unsigned c = xb_ld(&bar[XB_XCNT(j)]); sum += c; cnt += (c > 0u) ? 1u : 0u; mine = (j == x) ? c : mine; }
        if (sum == G) break;
        __builtin_amdgcn_s_sleep(1);
        if ((++sp & 255u) == 0u) { if (xb_ld(&bar[XB_TMO])) break; if (sp > XB_SPIN_CAP) { atomicAdd(&bar[XB_TMO], 1u); break; } }
    }
    nloc = mine > 0u ? mine : 1u; nx = cnt > 0u ? cnt : 1u;
}

__device__ __forceinline__ void xcd_barrier(const XcdBarrier& b) {
    asm volatile("s_waitcnt vmcnt(0)" ::: "memory");
    __syncthreads();
    if (threadIdx.x == 0) {
        unsigned* bar = b.bar;
        __builtin_amdgcn_s_waitcnt(0);
        unsigned nloc = b.st[0], nx = b.st[1];
        if (nloc == 0u) { xcd_barrier_complete(bar, b.x, nloc, nx); b.st[0] = nloc; b.st[1] = nx; }
        const unsigned old = xb_add(&bar[XB_XSUB(b.x)], 1u);
        const unsigned gen = old / nloc;
        if (old + 1u == (gen + 1u) * nloc) {
            __builtin_amdgcn_fence(__ATOMIC_RELEASE, "agent");
            asm volatile("s_waitcnt vmcnt(0)" ::: "memory");
            const unsigned og = xb_add(&bar[XB_TOP], 1u);
            const unsigned tg = og / nx;
            if (og + 1u == (tg + 1u) * nx) xb_add(&bar[XB_TOPGEN], 1u);
            else XB_SPIN(xb_ld(&bar[XB_TOPGEN]) == tg, bar);
            __builtin_amdgcn_fence(__ATOMIC_ACQUIRE, "agent");
            xb_add(&bar[XB_XGEN(b.x)], 1u);
            asm volatile("s_waitcnt vmcnt(0)" ::: "memory");
        } else {
            XB_SPIN(xb_ld(&bar[XB_XGEN(b.x)]) == gen, bar);
            __builtin_amdgcn_fence(__ATOMIC_ACQUIRE, "agent");
            asm volatile("s_waitcnt vmcnt(0)" ::: "memory");
        }
    }
    __syncthreads();
}


__device__ __forceinline__ void nret_scores(const bf16* Q, const bf16* K, float* S, int n, int gtid, int NT) {
    for (int idx = gtid; idx < 8 * 128 * 128; idx += NT) {
        const int j = idx & 127, i = (idx >> 7) & 127, bh = idx >> 14, b = bh >> 2, h = bh & 3;
        const bf16* q = Q + (size_t)(b * SEQ + n * RCH + i) * 1024 + h * RDK;
        const bf16* k = K + (size_t)(b * SEQ + n * RCH + j) * 1024 + h * RDK;
        float s = 0.f;
        for (int d = 0; d < RDK; ++d) s += bf2f(q[d]) * bf2f(k[d]);
        S[idx] = s;
    }
}
__device__ __forceinline__ void nret_out(const bf16* Q, const bf16* V, const float* S, const float* R, bf16* RET, int n, int gtid, int NT) {
    for (int idx = gtid; idx < 8 * 128 * 512; idx += NT) {
        const int e = idx & 511, i = (idx >> 9) & 127, bh = idx >> 16, b = bh >> 2, h = bh & 3;
        const float lg = ret_lg(h);
        const float* Srow = S + ((size_t)bh * 128 + i) * 128;
        float acc = 0.f;
        for (int j = 0; j <= i; ++j) acc += expf(lg * (float)(i - j)) * Srow[j] * bf2f(V[(size_t)(b * SEQ + n * RCH + j) * 2048 + h * RDV + e]);
        const bf16* q = Q + (size_t)(b * SEQ + n * RCH + i) * 1024 + h * RDK;
        const float* Rb = R + (size_t)bh * RDK * RDV + e;
        float cr = 0.f;
        if (n > 0) for (int d = 0; d < RDK; ++d) cr += bf2f(q[d]) * Rb[(size_t)d * RDV];
        acc += expf(lg * (float)(i + 1)) * cr;
        RET[(size_t)(b * SEQ + n * RCH + i) * 2048 + h * RDV + e] = (bf16)f2bf(acc);
    }
}
__device__ __forceinline__ void nret_state(const bf16* K, const bf16* V, float* R, int n, int gtid, int NT) {
    for (int idx = gtid; idx < 8 * 256 * 512; idx += NT) {
        const int e = idx & 511, d = (idx >> 9) & 255, bh = idx >> 17, b = bh >> 2, h = bh & 3;
        const float lg = ret_lg(h);
        float acc = 0.f;
        for (int j = 0; j < RCH; ++j) acc += expf(lg * (float)(RCH - 1 - j)) * bf2f(K[(size_t)(b * SEQ + n * RCH + j) * 1024 + h * RDK + d]) * bf2f(V[(size_t)(b * SEQ + n * RCH + j) * 2048 + h * RDV + e]);
        R[idx] = (n == 0 ? 0.f : expf(lg * (float)RCH) * R[idx]) + acc;
    }
}

__device__ __forceinline__ void nattn_block(int blk, bf16* Q, const bf16* K, const bf16* V, float lam, const float* subln_g, const float* rel_bias,
                                            LAS float* o1s, LAS float* btab, int lane) {
    const int qb = blk & 127, bh = blk >> 7, b = bh >> 4, h = bh & 15;
    const int t = qb * 64 + lane;
    btab[lane] = rel_bias[t5_bucket(lane) * 16 + h] * LOG2E; btab[lane + 64] = rel_bias[t5_bucket(lane + 64) * 16 + h] * LOG2E;
    LDS_WAIT(); __builtin_amdgcn_wave_barrier();
    const int kmax = qb * 64 + 63;
    float ss = 0.f;
    for (int map = 0; map < 2; ++map) {
        float q[64];
        const v4u* qp = (const v4u*)(Q + (size_t)(b * SEQ + t) * 2048 + h * 128 + map * 64);
#pragma unroll
        for (int c = 0; c < 8; ++c) { const v4u w = qp[c]; q[8*c] = bf_lo(w.x); q[8*c+1] = bf_hi(w.x); q[8*c+2] = bf_lo(w.y); q[8*c+3] = bf_hi(w.y);
            q[8*c+4] = bf_lo(w.z); q[8*c+5] = bf_hi(w.z); q[8*c+6] = bf_lo(w.w); q[8*c+7] = bf_hi(w.w); }
        float mx = -INFINITY;
        for (int k = 0; k <= kmax; ++k) {
            const v4u* kp = (const v4u*)(K + (size_t)(b * SEQ + k) * 2048 + h * 128 + map * 64);
            float s = 0.f;
#pragma unroll
            for (int c = 0; c < 8; ++c) { const v4u w = kp[c];
                s += q[8*c] * bf_lo(w.x) + q[8*c+1] * bf_hi(w.x) + q[8*c+2] * bf_lo(w.y) + q[8*c+3] * bf_hi(w.y)
                   + q[8*c+4] * bf_lo(w.z) + q[8*c+5] * bf_hi(w.z) + q[8*c+6] * bf_lo(w.w) + q[8*c+7] * bf_hi(w.w); }
            const int dist = t - k;
            if (dist >= 0) { s += btab[dist < 127 ? dist : 127]; mx = fmaxf(mx, s); }
        }
        for (int half = 0; half < 2; ++half) {
            float o[64];
#pragma unroll
            for (int e = 0; e < 64; ++e) o[e] = 0.f;
            float l = 0.f;
            for (int k = 0; k <= kmax; ++k) {
                const v4u* kp = (const v4u*)(K + (size_t)(b * SEQ + k) * 2048 + h * 128 + map * 64);
                float s = 0.f;
#pragma unroll
                for (int c = 0; c < 8; ++c) { const v4u w = kp[c];
                    s += q[8*c] * bf_lo(w.x) + q[8*c+1] * bf_hi(w.x) + q[8*c+2] * bf_lo(w.y) + q[8*c+3] * bf_hi(w.y)
                       + q[8*c+4] * bf_lo(w.z) + q[8*c+5] * bf_hi(w.z) + q[8*c+6] * bf_lo(w.w) + q[8*c+7] * bf_hi(w.w); }
                const int dist = t - k;
                float p = 0.f;
                if (dist >= 0) { s += btab[dist < 127 ? dist : 127]; p = exp2f(s - mx); }
                l += p;
                const v4u* vp = (const v4u*)(V + (size_t)(b * SEQ + k) * 2048 + h * 128 + half * 64);
#pragma unroll
                for (int c = 0; c < 8; ++c) { const v4u w = vp[c];
                    o[8*c] += p * bf_lo(w.x); o[8*c+1] += p * bf_hi(w.x); o[8*c+2] += p * bf_lo(w.y); o[8*c+3] += p * bf_hi(w.y);
                    o[8*c+4] += p * bf_lo(w.z); o[8*c+5] += p * bf_hi(w.z); o[8*c+6] += p * bf_lo(w.w); o[8*c+7] += p * bf_hi(w.w); }
            }
            const float linv = 1.0f / l;
            if (map == 0) {
#pragma unroll
                for (int e = 0; e < 64; ++e) o1s[(half * 64 + e) * 64 + lane] = o[e] * linv;
            } else {
#pragma unroll
                for (int e = 0; e < 64; ++e) { const float d = o1s[(half * 64 + e) * 64 + lane] - lam * (o[e] * linv); ss += d * d; o1s[(half * 64 + e) * 64 + lane] = d; }
            }
        }
    }
    {
        const float r = 1.0f / sqrtf(ss * (1.0f / 128.0f) + GN_EPS) * (1.0f - LAMBDA_INIT);
        bf16* op = Q + (size_t)(b * SEQ + t) * 2048 + h * 128;
#pragma unroll 8
        for (int e = 0; e < 128; e += 2) *(unsigned*)(op + e) = pk2(o1s[e * 64 + lane] * r * subln_g[e], o1s[(e + 1) * 64 + lane] * r * subln_g[e + 1]);
    }
    LDS_WAIT(); __builtin_amdgcn_wave_barrier();
}
__device__ __forceinline__ float diff_lambda(const float* lq1, const float* lk1, const float* lq2, const float* lk2) {
    float d1 = 0.f, d2 = 0.f;
    for (int i = 0; i < 64; ++i) { d1 += lq1[i] * lk1[i]; d2 += lq2[i] * lk2[i]; }
    return expf(d1) - expf(d2) + LAMBDA_INIT;
}

namespace da {
using bf16x8 = __attribute__((ext_vector_type(8))) short;
using s16x4 = __attribute__((ext_vector_type(4))) short;
using f32x16 = __attribute__((ext_vector_type(16))) float;
using u32x4 = __attribute__((ext_vector_type(4))) unsigned;
typedef short v4i16_t __attribute__((ext_vector_type(4)));
typedef LAS const char* lds_cptr;
constexpr int PITCH = 2048, KVB = 64, SLOT = 32768, OFF_K0 = 0, OFF_K1 = 8192, OFF_V = 16384;
constexpr int NSLOT = 4;
constexpr int LDS_WS = 131072;
constexpr int LDS_BT = 133120;
constexpr int LDS_X = 0;
constexpr int LDS_OST = 65536;
constexpr float THR = 8.0f;
#define DA_SBAR() __builtin_amdgcn_sched_barrier(0)
#define DA_MFMA(a, b, c) __builtin_amdgcn_mfma_f32_32x32x16_bf16(a, b, c, 0, 0, 0)
#define DA_WAIT_BAR(N) asm volatile("s_waitcnt vmcnt(" #N ") lgkmcnt(0)\n\ts_barrier" ::: "memory")
__device__ __forceinline__ int crow(int r, int hi) { return (r & 3) + 8 * (r >> 2) + 4 * hi; }
__device__ __forceinline__ void glds16(const void* gsrc, unsigned lds_dst) { unsigned keep;
    asm volatile("s_mov_b32 %0, m0\n\ts_mov_b32 m0, %2\n\ts_nop 0\n\tglobal_load_lds_dwordx4 %1, off\n\ts_mov_b32 m0, %0" : "=&s"(keep) : "v"(gsrc), "s"(lds_dst) : "memory"); }
__device__ __forceinline__ s16x4 vtr(lds_cptr p) { return __builtin_bit_cast(s16x4, __builtin_amdgcn_ds_read_tr16_b64_v4i16((LAS v4i16_t*)p)); }
__device__ __forceinline__ unsigned cvtpk(float lo, float hi) { typedef float f2 __attribute__((ext_vector_type(2))); typedef __bf16 b2 __attribute__((ext_vector_type(2)));
    f2 v = {lo, hi}; b2 b = __builtin_convertvector(v, b2); return __builtin_bit_cast(unsigned, b); }
#define DA_MX3(a, b, c) __builtin_fmaxf(__builtin_fmaxf((a), (b)), (c))
__device__ __forceinline__ float rowmax(const f32x16& p0, const f32x16& p1) {
    float a = DA_MX3(p0[0], p0[1], p1[0]), b = DA_MX3(p0[2], p0[3], p1[1]); a = DA_MX3(a, p1[2], p1[3]);
#pragma unroll
    for (int r = 4; r < 16; r += 4) { a = DA_MX3(a, p0[r], p0[r + 1]); b = DA_MX3(b, p0[r + 2], p0[r + 3]); a = DA_MX3(a, p1[r], p1[r + 1]); b = DA_MX3(b, p1[r + 2], p1[r + 3]); }
    float m = __builtin_fmaxf(a, b); auto rr = __builtin_amdgcn_permlane32_swap(__float_as_uint(m), __float_as_uint(m), false, false);
    return __builtin_fmaxf(__uint_as_float(rr[0]), __uint_as_float(rr[1])); }

template <bool STORE, int MODE = 0> __device__ __forceinline__ void attn_unit(int b, int h, int qb, bf16* Q, const bf16* K, const bf16* V, float lam, const float* subln_g, LAS char* shm) {
    int tid_ = threadIdx.x; asm volatile("" : "+v"(tid_));
    const int tid = tid_, lane = tid & 63, r32 = lane & 31, hi = lane >> 5; const int wid = __builtin_amdgcn_readfirstlane(tid >> 6);
    const int map = wid >> 2, qblk = wid & 3;
    const long rowbase = (long)b * SEQ; const int q0 = qb * 128; const int NT = 2 * qb + 2;
    const bf16* Qw = Q + (rowbase + q0 + qblk * 32) * PITCH + h * 128 + map * 64;
    const bf16* Kh = K + rowbase * PITCH + h * 128; const bf16* Vh = V + rowbase * PITCH + h * 128;
    const unsigned lds0 = (unsigned)(uintptr_t)shm;
    LAS float* wsf = (LAS float*)(shm + LDS_WS) + wid * 64;
    const LAS float* btab = (const LAS float*)(shm + LDS_BT);
    const bf16* ksrc = Kh + (long)lane * PITCH + wid * 8;
    const bf16* vsrc = Vh + (long)(16 * (wid & 3) + (lane >> 2)) * PITCH + (wid >> 2) * 32 + (lane & 3) * 8;
    const unsigned kdst = lds0 + OFF_K0 + wid * 1024, vdst = lds0 + OFF_V + wid * 1024;
#define DA_DMA(t, slot) do { if (MODE >= 2) break; const long go_ = (long)(t) * KVB * PITCH; const unsigned so_ = (unsigned)(slot); \
        glds16(ksrc + go_, (unsigned)__builtin_amdgcn_readfirstlane(kdst + so_)); glds16(ksrc + go_ + 64, (unsigned)__builtin_amdgcn_readfirstlane(kdst + so_ + 8192)); \
        glds16(vsrc + go_, (unsigned)__builtin_amdgcn_readfirstlane(vdst + so_)); glds16(vsrc + go_ + 64, (unsigned)__builtin_amdgcn_readfirstlane(vdst + so_ + 8192)); } while (0)
    const lds_cptr kp0 = (lds_cptr)shm + (map ? OFF_K1 : OFF_K0) + hi * 1024 + r32 * 16;
    const lds_cptr vp0 = (lds_cptr)shm + OFF_V + ((lane >> 4) & 1) * 32 + (lane & 3) * 8 + (4 * hi + ((lane & 15) >> 2)) * 64;
    DA_DMA(0, 0); DA_DMA(1, SLOT);
    bf16x8 qr[4];
#pragma unroll
    for (int d0 = 0; d0 < 4; ++d0) qr[d0] = *reinterpret_cast<const bf16x8*>(&Qw[(long)r32 * PITCH + d0 * 16 + hi * 8]);
    float mhat = 0.f, l_reg = 0.f;
    f32x16 o[4];
#pragma unroll
    for (int g = 0; g < 4; ++g) o[g] = f32x16{};
    bool moved = false;
    const f32x16 zero16 = f32x16{};
    const int qpos = q0 + qblk * 32 + r32;
#pragma unroll
    for (int d0 = 0; d0 < 4; ++d0) asm volatile("" : "+v"(qr[d0]));
    bf16x8 pa[4] = {};
#define DA_VLOAD(dst, g_) do { _Pragma("unroll") for (int ks_ = 0; ks_ < 4; ++ks_) { const s16x4 lo_ = vtr(vp + (g_) * 4096 + ks_ * 1024), hh_ = vtr(vp + (g_) * 4096 + ks_ * 1024 + 512); \
        dst[ks_] = (bf16x8){lo_[0], lo_[1], lo_[2], lo_[3], hh_[0], hh_[1], hh_[2], hh_[3]}; } } while (0)
#define DA_HEAD(t) do { if ((t) + 1 < NT) { DA_WAIT_BAR(4); } else { DA_WAIT_BAR(0); } \
        if ((t) + 2 < NT) DA_DMA((t) + 2, (((t) + 2) & 3) * SLOT); } while (0)
#define DA_QKS(t) do { \
        const lds_cptr kp = kp0 + ((t) & 3) * SLOT; \
        f32x16 c0, c1; \
        { bf16x8 kf[8]; \
          _Pragma("unroll") for (int j = 0; j < 4; ++j) { kf[2 * j] = *(const LAS bf16x8*)(kp + j * 2048); kf[2 * j + 1] = *(const LAS bf16x8*)(kp + j * 2048 + 512); } \
          DA_SBAR(); \
          c0 = DA_MFMA(kf[0], qr[0], zero16); c1 = DA_MFMA(kf[1], qr[0], zero16); \
          c0 = DA_MFMA(kf[2], qr[1], c0); c1 = DA_MFMA(kf[3], qr[1], c1); \
          c0 = DA_MFMA(kf[4], qr[2], c0); c1 = DA_MFMA(kf[5], qr[2], c1); \
          c0 = DA_MFMA(kf[6], qr[3], c0); c1 = DA_MFMA(kf[7], qr[3], c1); } \
        if (moved) { _Pragma("unroll") for (int r = 0; r < 16; ++r) { c0[r] -= mhat; c1[r] -= mhat; } } \
        if ((t) * KVB + 63 + 113 > q0 + qblk * 32) { \
            const int kb = (t) * KVB + 4 * hi; \
            _Pragma("unroll") for (int r = 0; r < 16; ++r) { \
                const int d0 = qpos - (kb + (r & 3) + 8 * (r >> 2)); const int d1 = d0 - 32; \
                c0[r] += btab[(d0 < 127 ? d0 : 127) + 127]; \
                c1[r] += btab[(d1 < 127 ? d1 : 127) + 127]; } } \
        { const float rm = rowmax(c0, c1); \
          if (__any(rm > THR)) { \
              const float dl = __builtin_fmaxf(rm, 0.f); mhat += dl; moved = true; \
              _Pragma("unroll") for (int r = 0; r < 16; ++r) { c0[r] -= dl; c1[r] -= dl; } \
              const float f = __builtin_amdgcn_exp2f(-dl); l_reg *= f; \
              if (hi == 0) wsf[r32] = f; \
              asm volatile("s_waitcnt lgkmcnt(0)" ::: "memory"); \
              _Pragma("unroll") for (int r = 0; r < 16; ++r) { const float fr = wsf[crow(r, hi)]; \
                  _Pragma("unroll") for (int g = 0; g < 4; ++g) o[g][r] *= fr; } } } \
        float sacc = 0.f; \
        _Pragma("unroll") for (int r = 0; r < 16; ++r) { c0[r] = __builtin_amdgcn_exp2f(c0[r]); c1[r] = __builtin_amdgcn_exp2f(c1[r]); sacc += c0[r] + c1[r]; } \
        l_reg += sacc; \
        { u32x4 w0 = {cvtpk(c0[0], c0[1]), cvtpk(c0[2], c0[3]), cvtpk(c0[4], c0[5]), cvtpk(c0[6], c0[7])}; \
          u32x4 w1 = {cvtpk(c0[8], c0[9]), cvtpk(c0[10], c0[11]), cvtpk(c0[12], c0[13]), cvtpk(c0[14], c0[15])}; \
          u32x4 w2 = {cvtpk(c1[0], c1[1]), cvtpk(c1[2], c1[3]), cvtpk(c1[4], c1[5]), cvtpk(c1[6], c1[7])}; \
          u32x4 w3 = {cvtpk(c1[8], c1[9]), cvtpk(c1[10], c1[11]), cvtpk(c1[12], c1[13]), cvtpk(c1[14], c1[15])}; \
          pa[0] = __builtin_bit_cast(bf16x8, w0); pa[1] = __builtin_bit_cast(bf16x8, w1); pa[2] = __builtin_bit_cast(bf16x8, w2); pa[3] = __builtin_bit_cast(bf16x8, w3); } \
    } while (0)
#define DA_PV(t) do { \
        const lds_cptr vp = vp0 + ((t) & 3) * SLOT; \
        bf16x8 va[4], vb[4], vc[4], vd[4]; \
        DA_VLOAD(va, 0); DA_VLOAD(vb, 1); \
        DA_SBAR(); \
        DA_VLOAD(vc, 2); \
        _Pragma("unroll") for (int ks = 0; ks < 4; ++ks) o[0] = DA_MFMA(pa[ks], va[ks], o[0]); \
        DA_SBAR(); \
        DA_VLOAD(vd, 3); \
        _Pragma("unroll") for (int ks = 0; ks < 4; ++ks) o[1] = DA_MFMA(pa[ks], vb[ks], o[1]); \
        DA_SBAR(); \
        _Pragma("unroll") for (int ks = 0; ks < 4; ++ks) o[2] = DA_MFMA(pa[ks], vc[ks], o[2]); \
        _Pragma("unroll") for (int ks = 0; ks < 4; ++ks) o[3] = DA_MFMA(pa[ks], vd[ks], o[3]); \
    } while (0)
    if (map == 0) {
#pragma unroll 1
        for (int t = 0; t < NT; ++t) { DA_HEAD(t); DA_QKS(t); DA_SBAR(); DA_PV(t); }
    } else {
        DA_HEAD(0); DA_QKS(0);
#pragma unroll 1
        for (int t = 1; t < NT; ++t) { DA_HEAD(t); DA_PV(t - 1); DA_SBAR(); DA_QKS(t); }
        DA_PV(NT - 1);
    }
#undef DA_VLOAD
#undef DA_HEAD
#undef DA_QKS
#undef DA_PV
    asm volatile("s_waitcnt vmcnt(0) lgkmcnt(0)\n\ts_barrier" ::: "memory");
    { auto rr = __builtin_amdgcn_permlane32_swap(__float_as_uint(l_reg), __float_as_uint(l_reg), false, false); l_reg = __uint_as_float(rr[0]) + __uint_as_float(rr[1]); }
    if (hi == 0) wsf[32 + r32] = l_reg;
    asm volatile("s_waitcnt lgkmcnt(0)" ::: "memory");
    float rli[16];
#pragma unroll
    for (int r = 0; r < 16; ++r) rli[r] = __builtin_amdgcn_rcpf(wsf[32 + crow(r, hi)]);
    LAS float* X = (LAS float*)(shm + LDS_X);
    if (map == 1) {
#pragma unroll
        for (int r = 0; r < 16; ++r)
#pragma unroll
            for (int g = 0; g < 4; ++g) X[(((wid - 4) * 16 + r) * 4 + g) * 64 + lane] = o[g][r] * rli[r];
    }
    asm volatile("s_waitcnt lgkmcnt(0)\n\ts_barrier" ::: "memory");
    if (map == 0) {
        float ss[16];
#pragma unroll
        for (int r = 0; r < 16; ++r) { float s = 0.f;
#pragma unroll
            for (int g = 0; g < 4; ++g) { const float d = o[g][r] * rli[r] - lam * X[((wid * 16 + r) * 4 + g) * 64 + lane]; o[g][r] = d; s += d * d; }
            ss[r] = s; }
#pragma unroll
        for (int r = 0; r < 16; ++r) { float s = ss[r];
            s += __shfl_xor(s, 1); s += __shfl_xor(s, 2); s += __shfl_xor(s, 4); s += __shfl_xor(s, 8); s += __shfl_xor(s, 16);
            ss[r] = (1.0f / sqrtf(s * (1.0f / 128.0f) + GN_EPS)) * (1.0f - LAMBDA_INIT); }
        float gsub[4];
#pragma unroll
        for (int g = 0; g < 4; ++g) gsub[g] = subln_g[32 * g + r32];
        LAS bf16* stg = (LAS bf16*)(shm + LDS_OST) + wid * 4096;
#pragma unroll
        for (int r = 0; r < 16; ++r) { const int orow = crow(r, hi);
#pragma unroll
            for (int g = 0; g < 4; ++g) stg[orow * 128 + 32 * g + r32] = (bf16)f2bf(o[g][r] * ss[r] * gsub[g]); }
        asm volatile("s_waitcnt lgkmcnt(0)" ::: "memory");
        bf16* Ow = Q + (rowbase + q0 + qblk * 32) * PITCH + h * 128;
#pragma unroll
        for (int i = 0; i < 8; ++i) { const int row = i * 4 + (lane >> 4), ch = lane & 15;
            const u32x4 v = *(const LAS u32x4*)(stg + row * 128 + ch * 8);
            if (STORE) *(u32x4*)(Ow + (long)row * PITCH + ch * 8) = v; else asm volatile("" :: "v"(v)); }
    }
    asm volatile("s_waitcnt vmcnt(0) lgkmcnt(0)\n\ts_barrier" ::: "memory");
#undef DA_DMA
}

template <bool STORE, int MODE = 0> __device__ __forceinline__ void attn_phase(LAS char* shm, bf16* Q, const bf16* K, const bf16* V, const float* lq1, const float* lk1, const float* lq2, const float* lk2,
                                           const float* subln_g, const float* rel_bias, int vcu, int G) {
    const float lam = diff_lambda(lq1, lk1, lq2, lk2);
    const int tid = threadIdx.x;
    for (int bh = vcu >> 3; bh < BATCH * AH; bh += (G >> 3)) {
        const int b = bh >> 4, h = bh & 15, s = vcu & 7;
        if (tid < 255) ((LAS float*)(shm + LDS_BT))[tid] = tid < 127 ? -INFINITY : (rel_bias[t5_bucket(tid - 127) * 16 + h] - rel_bias[31 * 16 + h]) * LOG2E;
        asm volatile("s_waitcnt lgkmcnt(0)\n\ts_barrier" ::: "memory");
#pragma unroll 1
        for (int i = 0; i < 8; ++i) {
            const int base = (i >> 1) * 16; const int qb = (i & 1) ? base + 15 - s : base + s;
            attn_unit<STORE, MODE>(b, h, qb, Q, K, V, lam, subln_g, shm);
        }
    }
}
#undef DA_SBAR
#undef DA_MFMA
#undef DA_WAIT_BAR
#undef DA_MX3
}

namespace rt {
using bf16x8 = __attribute__((ext_vector_type(8))) short;
using s16x4 = __attribute__((ext_vector_type(4))) short;
using f32x4v = __attribute__((ext_vector_type(4))) float;
using u32x4 = __attribute__((ext_vector_type(4))) unsigned;
constexpr int QS = 264, KS = 264, KT = 72, VT = 72, SS = 72;
constexpr int OFF_Q = 0, OFF_K = OFF_Q + 64 * QS * 2, OFF_KT = OFF_K + 64 * KS * 2, OFF_VT = OFF_KT + 256 * KT * 2, OFF_S = OFF_VT + 128 * VT * 2, LDS_END = OFF_S + 64 * SS * 2;
#define RT_MFMA(a, b, c) __builtin_amdgcn_mfma_f32_16x16x32_bf16(a, b, c, 0, 0, 0)

template <bool FULL, bool STORE> __device__ __forceinline__ void ret_unit(int unit, const bf16* Q, const bf16* K, bf16* V, float* E, LAS char* shm) {
    int tid_ = threadIdx.x; asm volatile("" : "+v"(tid_));
    const int tid = tid_, lane = tid & 63, c = lane & 15, g = lane >> 4; const int wid = __builtin_amdgcn_readfirstlane(tid >> 6);
    const int seg = unit & 7, dvs = (unit >> 3) & 3, bh = unit >> 5, b = bh >> 2, h = bh & 3;
    if (!FULL && seg == 7) return;
    const float lg2 = __builtin_amdgcn_logf(1.0f - __builtin_amdgcn_exp2f(-5.0f - (float)h));
    const float d64 = __builtin_amdgcn_exp2f(64.0f * lg2), d1024 = __builtin_amdgcn_exp2f(1024.0f * lg2);
    const size_t tok0 = (size_t)b * SEQ + (size_t)seg * 1024;
    const bf16* Qg = Q + tok0 * 1024 + h * 256; const bf16* Kg = K + tok0 * 1024 + h * 256;
    bf16* Vg = V + tok0 * 2048 + h * 512 + dvs * 128;
    LAS bf16* Qs = (LAS bf16*)(shm + OFF_Q); LAS bf16* Ks = (LAS bf16*)(shm + OFF_K); LAS bf16* KTs = (LAS bf16*)(shm + OFF_KT);
    LAS bf16* VTs = (LAS bf16*)(shm + OFF_VT); LAS bf16* Ss = (LAS bf16*)(shm + OFF_S);
    f32x4v R[16];
#pragma unroll
    for (int kt = 0; kt < 16; ++kt) R[kt] = (f32x4v){0.f, 0.f, 0.f, 0.f};
    if (FULL) {
        for (int j = 0; j < seg; ++j) {
            const float* Ej = E + ((size_t)(unit - seg + j) * 8 + wid) * 4096 + lane;
#pragma unroll
            for (int kt = 0; kt < 16; ++kt)
#pragma unroll
                for (int r = 0; r < 4; ++r) R[kt][r] = d1024 * R[kt][r] + Ej[(kt * 4 + r) * 64];
        }
    }
    u32x4 pq[4], pk[4], pv[2];
#define RT_LOAD(step) do { \
        if (FULL) { _Pragma("unroll") for (int it = 0; it < 4; ++it) pq[it] = *(const u32x4*)(Qg + (size_t)((step) * 64 + (tid >> 5) + 16 * it) * 1024 + (tid & 31) * 8); } \
        _Pragma("unroll") for (int it = 0; it < 4; ++it) pk[it] = *(const u32x4*)(Kg + (size_t)((step) * 64 + lane) * 1024 + (wid * 4 + it) * 8); \
        _Pragma("unroll") for (int it = 0; it < 2; ++it) pv[it] = *(const u32x4*)(Vg + (size_t)((step) * 64 + lane) * 2048 + (wid * 2 + it) * 8); } while (0)
#define RT_STORE() do { \
        if (FULL) { _Pragma("unroll") for (int it = 0; it < 4; ++it) *(LAS u32x4*)(Qs + ((tid >> 5) + 16 * it) * QS + (tid & 31) * 8) = pq[it]; \
                    _Pragma("unroll") for (int it = 0; it < 4; ++it) *(LAS u32x4*)(Ks + lane * KS + (wid * 4 + it) * 8) = pk[it]; } \
        _Pragma("unroll") for (int it = 0; it < 4; ++it) { const int d0_ = (wid * 4 + it) * 8; \
            _Pragma("unroll") for (int w_ = 0; w_ < 4; ++w_) { const unsigned x_ = pk[it][w_]; KTs[(d0_ + 2 * w_) * KT + lane] = (bf16)(x_ & 0xffffu); KTs[(d0_ + 2 * w_ + 1) * KT + lane] = (bf16)(x_ >> 16); } } \
        _Pragma("unroll") for (int it = 0; it < 2; ++it) { const int d0_ = (wid * 2 + it) * 8; \
            _Pragma("unroll") for (int w_ = 0; w_ < 4; ++w_) { const unsigned x_ = pv[it][w_]; VTs[(d0_ + 2 * w_) * VT + lane] = (bf16)(x_ & 0xffffu); VTs[(d0_ + 2 * w_ + 1) * VT + lane] = (bf16)(x_ >> 16); } } } while (0)
    RT_LOAD(0);
    RT_STORE();
#pragma unroll 1
    for (int step = 0; step < 16; ++step) {
        __syncthreads();
        if (step + 1 < 16) RT_LOAD(step + 1);
        if (FULL) {
            const int qt_s = wid >> 1;
#pragma unroll
            for (int u = 0; u < 2; ++u) {
                const int kt2 = 2 * (wid & 1) + u;
                f32x4v s = (f32x4v){0.f, 0.f, 0.f, 0.f};
                if (kt2 <= qt_s) {
#pragma unroll
                    for (int kk = 0; kk < 8; ++kk) {
                        const bf16x8 a = *(const LAS bf16x8*)(Qs + (16 * qt_s + c) * QS + kk * 32 + 8 * g);
                        const bf16x8 bb = *(const LAS bf16x8*)(Ks + (16 * kt2 + c) * KS + kk * 32 + 8 * g);
                        s = RT_MFMA(a, bb, s);
                        if (kk & 1) __builtin_amdgcn_sched_barrier(0);
                    }
                    if (kt2 == qt_s) {
#pragma unroll
                        for (int r = 0; r < 4; ++r) if (c > 4 * g + r) s[r] = 0.f;
                    }
                }
#pragma unroll
                for (int r = 0; r < 4; ++r) Ss[(16 * qt_s + 4 * g + r) * SS + 16 * kt2 + c] = (bf16)f2bf(s[r]);
            }
            f32x4v RT[4];
#pragma unroll
            for (int qt = 0; qt < 4; ++qt) RT[qt] = (f32x4v){0.f, 0.f, 0.f, 0.f};
#pragma unroll
            for (int kb = 0; kb < 8; ++kb) {
                u32x4 bw; bw.x = pg8::cvt_pk_bf16(R[2 * kb][0], R[2 * kb][1]); bw.y = pg8::cvt_pk_bf16(R[2 * kb][2], R[2 * kb][3]);
                bw.z = pg8::cvt_pk_bf16(R[2 * kb + 1][0], R[2 * kb + 1][1]); bw.w = pg8::cvt_pk_bf16(R[2 * kb + 1][2], R[2 * kb + 1][3]);
                const bf16x8 bb = __builtin_bit_cast(bf16x8, bw);
#pragma unroll
                for (int qt = 0; qt < 4; ++qt) {
                    const s16x4 lo = *(const LAS s16x4*)(Qs + (16 * qt + c) * QS + 32 * kb + 4 * g);
                    const s16x4 hh = *(const LAS s16x4*)(Qs + (16 * qt + c) * QS + 32 * kb + 16 + 4 * g);
                    const bf16x8 a = {lo[0], lo[1], lo[2], lo[3], hh[0], hh[1], hh[2], hh[3]};
                    RT[qt] = RT_MFMA(a, bb, RT[qt]);
                }
                __builtin_amdgcn_sched_barrier(0);
            }
            __syncthreads();
#pragma unroll
            for (int kk = 0; kk < 2; ++kk) {
                const bf16x8 bb = *(const LAS bf16x8*)(VTs + (16 * wid + c) * VT + kk * 32 + 8 * g);
#pragma unroll
                for (int qt = 0; qt < 4; ++qt) {
                    const bf16x8 a = *(const LAS bf16x8*)(Ss + (16 * qt + c) * SS + kk * 32 + 8 * g);
                    RT[qt] = RT_MFMA(a, bb, RT[qt]);
                }
            }
#pragma unroll
            for (int qt = 0; qt < 4; ++qt)
#pragma unroll
                for (int r = 0; r < 4; ++r) { if (STORE) Vg[(size_t)(step * 64 + 16 * qt + 4 * g + r) * 2048 + 16 * wid + c] = (bf16)f2bf(RT[qt][r]); else asm volatile("" :: "v"(RT[qt][r])); }
        }
#pragma unroll
        for (int kk = 0; kk < 2; ++kk) {
            const bf16x8 bb = *(const LAS bf16x8*)(VTs + (16 * wid + c) * VT + kk * 32 + 8 * g);
#pragma unroll
            for (int kt = 0; kt < 16; ++kt) {
                const bf16x8 a = *(const LAS bf16x8*)(KTs + (16 * kt + c) * KT + kk * 32 + 8 * g);
                R[kt] = RT_MFMA(a, bb, R[kt]);
                if ((kt & 3) == 3) __builtin_amdgcn_sched_barrier(0);
            }
        }
#pragma unroll
        for (int kt = 0; kt < 16; ++kt) R[kt] = R[kt] * d64;
        __syncthreads();
        if (step + 1 < 16) RT_STORE();
    }
    if (!FULL) {
        float* Eu = E + ((size_t)unit * 8 + wid) * 4096 + lane;
#pragma unroll
        for (int kt = 0; kt < 16; ++kt)
#pragma unroll
            for (int r = 0; r < 4; ++r) Eu[(kt * 4 + r) * 64] = R[kt][r];
    }
    __syncthreads();
#undef RT_LOAD
#undef RT_STORE
}
#undef RT_MFMA
}

constexpr int RING_OFF = 0, RING_BYTES = 143360;
constexpr int LDSCTL_OFF = RING_BYTES, MISC_OFF = LDSCTL_OFF + 320;
constexpr int LDS_BYTES = 147456;

#ifndef PROBE_ATT
#define PROBE_ATT 0
#endif
#ifndef PROBE_ATT_MODE
#define PROBE_ATT_MODE 0
#endif
#ifndef PROBE_RET
#define PROBE_RET 0
#endif
#ifndef PROBE_GEMM
#define PROBE_GEMM 0
#endif
#ifndef PROBE_MISC
#define PROBE_MISC 0
#endif
struct Frame {
    LAS unsigned char* lds;
    volatile LAS unsigned* MISC;
    gu32* ctl;
    int tid, lane, wave;
    int vcu, G;
};

struct Args { const float* in[13]; float* out; unsigned char* ws; int ph_lo, ph_hi; };

__global__ void __launch_bounds__(NTHREADS, 2) mega_fwd(Args args) {
    extern __shared__ __attribute__((aligned(16))) unsigned char lds[];
    Frame F;
    F.lds = (LAS unsigned char*)lds;
    F.MISC = (volatile LAS unsigned*)(F.lds + MISC_OFF);
    F.tid = threadIdx.x; F.lane = F.tid & 63; F.wave = __builtin_amdgcn_readfirstlane(F.tid >> 6);
    F.G = gridDim.x; { const int bx = blockIdx.x; F.vcu = (F.G % 8 == 0) ? (bx % 8) * (F.G / 8) + bx / 8 : bx; }
    unsigned char* ws = args.ws;
    F.ctl = (gu32*)(ws + WS_CTL);
    const float* x = args.in[0]; const float* pre_g = args.in[1]; const float* post_g = args.in[2];
    const float* ret_w_in = args.in[3]; const float* ret_w_out = args.in[4];
    const float* diff_w_in = args.in[5]; const float* diff_w_out = args.in[6];
    const float* lq1 = args.in[7]; const float* lk1 = args.in[8]; const float* lq2 = args.in[9]; const float* lk2 = args.in[10];
    const float* subln_g = args.in[11]; const float* rel_bias = args.in[12];
    float* out = args.out;
    bf16* W0in = (bf16*)(ws + WS_W0IN); bf16* W0out = (bf16*)(ws + WS_W0OUT); bf16* XN = (bf16*)(ws + WS_XN);
    bf16* Q0 = (bf16*)(ws + WS_Q0); bf16* K0 = (bf16*)(ws + WS_K0); bf16* V0 = (bf16*)(ws + WS_V0); bf16* G0 = (bf16*)(ws + WS_G0);
    bf16* Q1 = (bf16*)(ws + WS_Q1); bf16* K1 = (bf16*)(ws + WS_K1); bf16* V1 = (bf16*)(ws + WS_V1);
    bf16* W1g = (bf16*)(ws + WS_W1G); bf16* W1out = (bf16*)(ws + WS_W1OUT);
    float* YF0 = (float*)(ws + WS_YF_L0); float* YF1 = (float*)(ws + WS_YF_L1);

    for (int u = F.tid; u < (LDS_BYTES - LDSCTL_OFF) / 4; u += NTHREADS) ((LAS unsigned*)(F.lds + LDSCTL_OFF))[u] = 0u;
    __syncthreads();
    XcdBarrier bar = xcd_barrier_post((unsigned*)(F.ctl + CW_BAR), F.MISC + 8);
#define GRID_BAR() xcd_barrier(bar)

    const int gw = F.vcu * NWAVES + F.wave, NGW = F.G * NWAVES;
    const int gtid = F.vcu * NTHREADS + F.tid, NT = F.G * NTHREADS;
    LAS float* scr = (LAS float*)(F.lds + RING_OFF + F.wave * 16384);

    for (int rep = 0; rep < 1 + PROBE_MISC; ++rep) {
    transpose_all(ret_w_in, DM, RET_COLS, W0in, 0, RET_COLS, scr, gw, NGW, F.lane);
    transpose_all(ret_w_out, DI, DM, W0out, 0, DM, scr, gw, NGW, F.lane);
    norm_rows(x, nullptr, nullptr, pre_g, nullptr, XN, 0, gw, NGW, F.lane); }
    GRID_BAR();

    {
        pg8::Gemm g{XN, W0in, MROWS, RET_COLS, DM}; pg8::StaticOrder S; S.init(MROWS, RET_COLS, F.G, (int)blockIdx.x);
        pg8::EpiRetIn<true> E{Q0, K0, V0, G0};
        for (int rep = 0; rep < 1 + PROBE_GEMM; ++rep)
            pg8::gemm_phase<pg8::EpiRetIn<true>, pg8::StaticOrder, PG8_ALIGN, PG8_SP2>(F.lds + RING_OFF, g, S, E);
    }
    GRID_BAR();

    {
        float* Ebuf = (float*)(ws + WS_XN);
        transpose_all(diff_w_in, DM, DIFF_COLS, W0in, 0, DIFF_QKV_COLS, scr, gw, NGW, F.lane);
        transpose_all(diff_w_in, DM, DIFF_COLS, W1g, DIFF_QKV_COLS, DIFF_COLS, scr, gw, NGW, F.lane);
        transpose_all(diff_w_out, DI, DM, W1out, 0, DM, scr, gw, NGW, F.lane);
        __syncthreads();
        for (int rep = 0; rep < 1 + PROBE_RET; ++rep) for (int u = F.vcu; u < 256; u += F.G) rt::ret_unit<false, true>(u, Q0, K0, V0, Ebuf, (LAS char*)(F.lds + RING_OFF));
        GRID_BAR();
        for (int rep = 0; rep < PROBE_RET; ++rep) for (int u = F.vcu; u < 256; u += F.G) rt::ret_unit<true, false>(u, Q0, K0, V0, Ebuf, (LAS char*)(F.lds + RING_OFF));
        for (int u = F.vcu; u < 256; u += F.G) rt::ret_unit<true, true>(u, Q0, K0, V0, Ebuf, (LAS char*)(F.lds + RING_OFF));
        GRID_BAR();
        gn_gate_rows(V0, G0, gw, NGW, F.lane);
    }
    GRID_BAR();

    {
        pg8::Gemm g{G0, W0out, MROWS, DM, DI}; pg8::StaticOrder S; S.init(MROWS, DM, F.G, (int)blockIdx.x);
        pg8::EpiF32 E{YF0, DM, 0};
        for (int rep = 0; rep < 1 + PROBE_GEMM; ++rep)
            pg8::gemm_phase<pg8::EpiF32, pg8::StaticOrder, PG8_ALIGN, PG8_SP2>(F.lds + RING_OFF, g, S, E);
    }
    GRID_BAR();
    for (int rep = 0; rep < 1 + PROBE_MISC; ++rep) norm_rows(YF0, x, post_g, pre_g + DM, out, XN, 1, gw, NGW, F.lane);
    GRID_BAR();

    {
        pg8::Gemm g{XN, W0in, MROWS, DIFF_QKV_COLS, DM}; pg8::StaticOrder S; S.init(MROWS, DIFF_QKV_COLS, F.G, (int)blockIdx.x);
        pg8::EpiBf16S E{Q1, (size_t)(WS_K1 - WS_Q1) / 2, DI, DI, QSCALE2, 0};
        for (int rep = 0; rep < 1 + PROBE_GEMM; ++rep)
            pg8::gemm_phase<pg8::EpiBf16S, pg8::StaticOrder, PG8_ALIGN, PG8_SP2>(F.lds + RING_OFF, g, S, E);
    }
    GRID_BAR();

    for (int rep = 0; rep < PROBE_ATT; ++rep) da::attn_phase<false, PROBE_ATT_MODE>((LAS char*)(F.lds + RING_OFF), Q1, K1, V1, lq1, lk1, lq2, lk2, subln_g, rel_bias, F.vcu, F.G);
    da::attn_phase<true>((LAS char*)(F.lds + RING_OFF), Q1, K1, V1, lq1, lk1, lq2, lk2, subln_g, rel_bias, F.vcu, F.G);
    GRID_BAR();

    {
        pg8::Gemm g{XN, W1g, MROWS, DI, DM}; pg8::StaticOrder S; S.init(MROWS, DI, F.G, (int)blockIdx.x);
        pg8::EpiGate E{Q1, DI, 0};
        for (int rep = 0; rep < PROBE_GEMM; ++rep) { pg8::EpiGateT<false> E2{Q1, DI, 0}; pg8::gemm_phase<pg8::EpiGateT<false>, pg8::StaticOrder, PG8_ALIGN, PG8_SP2>(F.lds + RING_OFF, g, S, E2); }
        pg8::gemm_phase<pg8::EpiGate, pg8::StaticOrder, PG8_ALIGN, PG8_SP2>(F.lds + RING_OFF, g, S, E);
    }
    GRID_BAR();

    {
        pg8::Gemm g{Q1, W1out, MROWS, DM, DI}; pg8::StaticOrder S; S.init(MROWS, DM, F.G, (int)blockIdx.x);
        pg8::EpiF32 E{YF1, DM, 0};
        for (int rep = 0; rep < 1 + PROBE_GEMM; ++rep)
            pg8::gemm_phase<pg8::EpiF32, pg8::StaticOrder, PG8_ALIGN, PG8_SP2>(F.lds + RING_OFF, g, S, E);
    }
    GRID_BAR();
    norm_rows(YF1, out, post_g + DM, nullptr, out, nullptr, 2, gw, NGW, F.lane);
}

extern "C" void kernel_launch(void* const* d_in, const int* in_sizes, int n_in, void* d_out, int out_size, void* d_ws, size_t ws_size, hipStream_t stream) {
    static int grid = 0;
    if (grid == 0) {
        if (n_in != 13 || out_size != MROWS * DM || ws_size < WS_END) { fprintf(stderr, "kernel_launch: unexpected shapes (n_in %d out %d ws %zu)\n", n_in, out_size, ws_size); grid = -1; return; }
        int dev = 0, cus = 0, per_cu = 0;
        if (hipGetDevice(&dev) != hipSuccess || hipDeviceGetAttribute(&cus, hipDeviceAttributeMultiprocessorCount, dev) != hipSuccess) { grid = -1; return; }
        if (hipFuncSetAttribute((const void*)mega_fwd, hipFuncAttributeMaxDynamicSharedMemorySize, LDS_BYTES) != hipSuccess) { fprintf(stderr, "kernel_launch: hipFuncSetAttribute failed\n"); grid = -1; return; }
        if (hipOccupancyMaxActiveBlocksPerMultiprocessor(&per_cu, (const void*)mega_fwd, NTHREADS, LDS_BYTES) != hipSuccess || per_cu < 1)
            fprintf(stderr, "kernel_launch: occupancy query reports %d workgroups per CU\n", per_cu);
        (void)hipGetLastError();
        grid = cus;
        if (grid != 256) fprintf(stderr, "kernel_launch: %d CUs (built for 256)\n", grid);
    }
    if (grid < 0) return;
    if (hipMemsetAsync((char*)d_ws + WS_CTL, 0, CTL_ZERO_BYTES, stream) != hipSuccess) { fprintf(stderr, "kernel_launch: memset failed\n"); return; }
    Args a; memset(&a, 0, sizeof(a));
    for (int i = 0; i < 13; ++i) a.in[i] = (const float*)d_in[i];
    a.out = (float*)d_out; a.ws = (unsigned char*)d_ws; a.ph_lo = 0; a.ph_hi = 100;
    hipLaunchKernelGGL(mega_fwd, dim3(grid), dim3(NTHREADS), LDS_BYTES, stream, a);
}
```

```cpp
#include <hip/hip_runtime.h>
#include <cstdio>
#include <cstdint>
#include <cstring>
#include <cmath>
namespace pg8 {
#define PG8_LAS __attribute__((address_space(3)))
typedef unsigned short bf16_t;
typedef short bf16x8 __attribute__((ext_vector_type(8)));
typedef float f32x4 __attribute__((ext_vector_type(4)));
typedef unsigned u32x4 __attribute__((ext_vector_type(4)));
constexpr int BM = 256, BK = 64, HALF = 128, HTB = HALF * BK * 2  , STAGE_BYTES = 8 * HTB, NXCD = 8, WGM = 8;

__host__ __device__ __forceinline__ int lds_byte(int r, int c) { const int st = (r >> 4) * 2 + (c >> 5), rr = r & 15, cc = c & 31, ob = rr * 64 + cc * 2; return st * 1024 + (ob ^ (((ob >> 9) & 1) << 5)); }
__host__ __device__ __forceinline__ void stage_rc(int b, int& R, int& C) { const int st = b / 1024, sb = b % 1024, swz = sb ^ (((sb >> 9) & 1) << 5); R = (st >> 1) * 16 + swz / 64; C = (st & 1) * 32 + (swz % 64) / 2; }
__host__ __device__ __forceinline__ int perm32(int rho) { const int n = rho >> 4, i = rho & 15; return 8 * (i >> 2) + 4 * n + (i & 3); }

struct Unit { int pm, pn; };
struct Gemm { const bf16_t* A; const bf16_t* Bt; int M, N, K; };

struct StaticOrder {
    int nM, nN, nwg, G, c;
    __host__ __device__ void init(int M, int N, int G_, int c_) { nM = M / BM; nN = N / BM; nwg = nM * nN; G = G_; c = c_; }
    __host__ __device__ bool next(int i, Unit& u) const {
        const long L = (long)i * G + c; if (L >= nwg) return false;
        int wgid = (int)L; { const int q = nwg / NXCD, r = nwg % NXCD, xcd = wgid % NXCD, off = wgid / NXCD; wgid = (xcd < r ? xcd * (q + 1) : r * (q + 1) + (xcd - r) * q) + off; }
        const int nig = WGM * nN, gid = wgid / nig, fm = gid * WGM, gsz = (nM - fm) < WGM ? (nM - fm) : WGM;
        u.pm = fm + ((wgid % nig) % gsz); u.pn = (wgid % nig) / gsz; return true;
    }
    __device__ __forceinline__ void a_ready(const Unit&) const {}
    __device__ __forceinline__ void done(const Unit&) const {}
};


__device__ __forceinline__ unsigned cvt_pk_bf16(float lo, float hi) { unsigned r; asm volatile("v_cvt_pk_bf16_f32 %0, %1, %2" : "=v"(r) : "v"(lo), "v"(hi)); return r; }
__device__ __forceinline__ float silu_f(float x) { return x * __builtin_amdgcn_rcpf(1.0f + __builtin_amdgcn_exp2f(-1.4426950408889634f * x)); }
__device__ __forceinline__ float bf_lo(unsigned w) { return __uint_as_float(w << 16); }
__device__ __forceinline__ float bf_hi(unsigned w) { return __uint_as_float(w & 0xffff0000u); }

struct EpiBf16S {
    static constexpr bool PERM = true, AFTER_DRAIN = false;
    bf16_t* O; size_t split_stride; int ldc; int split_cols; float scale0; int pad;
    __device__ __forceinline__ void operator()(const f32x4 (&acc)[2][2][4][2], const Unit& u, int wr, int wc, int fr, int fq) const {
        const int row0 = u.pm * BM + wr * 64 + fr; int colt = u.pn * BM; bf16_t* base = O;
        float sc = 1.f; if (split_cols) { const int t = colt / split_cols; base += (size_t)t * split_stride; colt -= t * split_cols; if (t == 0) sc = scale0; }
        const int col0 = colt + wc * 32 + 8 * fq;
#pragma unroll
        for (int ai = 0; ai < 2; ++ai)
#pragma unroll
            for (int m = 0; m < 4; ++m) { bf16_t* rowp = base + (size_t)(row0 + ai * HALF + m * 16) * ldc + col0;
#pragma unroll
                for (int bj = 0; bj < 2; ++bj) { f32x4 v0 = acc[ai][bj][m][0] * sc, v1 = acc[ai][bj][m][1] * sc;
                    u32x4 w; w.x = cvt_pk_bf16(v0[0], v0[1]); w.y = cvt_pk_bf16(v0[2], v0[3]); w.z = cvt_pk_bf16(v1[0], v1[1]); w.w = cvt_pk_bf16(v1[2], v1[3]);
                    *(u32x4*)(rowp + bj * HALF) = w; } }
    }
};

struct EpiF32 {
    static constexpr bool PERM = false, AFTER_DRAIN = false;
    float* O; int ldc; int pad;
    __device__ __forceinline__ void operator()(const f32x4 (&acc)[2][2][4][2], const Unit& u, int wr, int wc, int fr, int fq) const {
        const int row0 = u.pm * BM + wr * 64 + fr; const int col0 = u.pn * BM + wc * 32 + 4 * fq;
#pragma unroll
        for (int ai = 0; ai < 2; ++ai)
#pragma unroll
            for (int m = 0; m < 4; ++m) { float* rowp = O + (size_t)(row0 + ai * HALF + m * 16) * ldc + col0;
#pragma unroll
                for (int bj = 0; bj < 2; ++bj)
#pragma unroll
                    for (int n = 0; n < 2; ++n) *(f32x4*)(rowp + bj * HALF + n * 16) = acc[ai][bj][m][n]; }
    }
};

template <bool FOLD> struct EpiRetIn {
    static constexpr bool PERM = true, AFTER_DRAIN = false;
    bf16_t *Q, *K, *V, *G;
    __device__ __forceinline__ void operator()(const f32x4 (&acc)[2][2][4][2], const Unit& u, int wr, int wc, int fr, int fq) const {
        const int row0 = u.pm * BM + wr * 64 + fr; const int c8 = wc * 32 + 8 * fq; const int pn = u.pn;
        if (pn < 8) {
            const bool isq = pn < 4; const int head = pn & 3;
            bf16_t* base = (isq ? Q : K) + head * 256 + c8;
            float wv[8];
#pragma unroll
            for (int j = 0; j < 8; ++j) wv[j] = __builtin_amdgcn_exp2f(-(float)(c8 + j) * (13.287712379549449f / 128.0f)) * 0.15915494309189535f;
            const float lg2 = __log2f(1.0f - __builtin_amdgcn_exp2f(-5.0f - (float)head));
#pragma unroll
            for (int ai = 0; ai < 2; ++ai)
#pragma unroll
                for (int m = 0; m < 4; ++m) {
                    const int row = row0 + ai * HALF + m * 16; const int t = row & 8191; const float pos = (float)t;
                    float sc = isq ? 1.0f : 0.0625f;
                    if (FOLD) { const float e = (float)((t & 63) + 1) * lg2; sc *= __builtin_amdgcn_exp2f(isq ? e : -e); }
                    float o1[8], o2[8];
#pragma unroll
                    for (int n = 0; n < 2; ++n)
#pragma unroll
                        for (int i = 0; i < 4; ++i) { const int j = 4 * n + i;
                            float rev = pos * wv[j]; rev = __builtin_amdgcn_fractf(rev);
                            const float cs = __builtin_amdgcn_cosf(rev), sn = __builtin_amdgcn_sinf(rev);
                            const float x1 = acc[ai][0][m][n][i], x2 = acc[ai][1][m][n][i];
                            o1[j] = (x1 * cs - x2 * sn) * sc; o2[j] = (x1 * sn + x2 * cs) * sc; }
                    u32x4 w1, w2;
                    w1.x = cvt_pk_bf16(o1[0], o1[1]); w1.y = cvt_pk_bf16(o1[2], o1[3]); w1.z = cvt_pk_bf16(o1[4], o1[5]); w1.w = cvt_pk_bf16(o1[6], o1[7]);
                    w2.x = cvt_pk_bf16(o2[0], o2[1]); w2.y = cvt_pk_bf16(o2[2], o2[3]); w2.z = cvt_pk_bf16(o2[4], o2[5]); w2.w = cvt_pk_bf16(o2[6], o2[7]);
                    bf16_t* rp = base + (size_t)row * 1024;
                    *(u32x4*)(rp) = w1; *(u32x4*)(rp + HALF) = w2;
                }
        } else {
            const bool isv = pn < 16; const int colt = (isv ? pn - 8 : pn - 16) * BM;
            bf16_t* base = (isv ? V : G) + colt + c8;
#pragma unroll
            for (int ai = 0; ai < 2; ++ai)
#pragma unroll
                for (int m = 0; m < 4; ++m) { bf16_t* rowp = base + (size_t)(row0 + ai * HALF + m * 16) * 2048;
#pragma unroll
                    for (int bj = 0; bj < 2; ++bj) { f32x4 v0 = acc[ai][bj][m][0], v1 = acc[ai][bj][m][1];
                        if (!isv) {
#pragma unroll
                            for (int i = 0; i < 4; ++i) { v0[i] = silu_f(v0[i]); v1[i] = silu_f(v1[i]); } }
                        u32x4 w; w.x = cvt_pk_bf16(v0[0], v0[1]); w.y = cvt_pk_bf16(v0[2], v0[3]); w.z = cvt_pk_bf16(v1[0], v1[1]); w.w = cvt_pk_bf16(v1[2], v1[3]);
                        *(u32x4*)(rowp + bj * HALF) = w; } }
        }
    }
};

template <bool STORE> struct EpiGateT {
    static constexpr bool PERM = true, AFTER_DRAIN = false;
    bf16_t* O; int ldc; int pad;
    __device__ __forceinline__ void operator()(const f32x4 (&acc)[2][2][4][2], const Unit& u, int wr, int wc, int fr, int fq) const {
        const int row0 = u.pm * BM + wr * 64 + fr; const int col0 = u.pn * BM + wc * 32 + 8 * fq;
#pragma unroll
        for (int ai = 0; ai < 2; ++ai)
#pragma unroll
            for (int m = 0; m < 4; ++m) { bf16_t* rowp = O + (size_t)(row0 + ai * HALF + m * 16) * ldc + col0;
#pragma unroll
                for (int bj = 0; bj < 2; ++bj) { const f32x4 v0 = acc[ai][bj][m][0], v1 = acc[ai][bj][m][1];
                    const u32x4 ov = *(const u32x4*)(rowp + bj * HALF);
                    u32x4 w;
                    w.x = cvt_pk_bf16(silu_f(v0[0]) * bf_lo(ov.x), silu_f(v0[1]) * bf_hi(ov.x));
                    w.y = cvt_pk_bf16(silu_f(v0[2]) * bf_lo(ov.y), silu_f(v0[3]) * bf_hi(ov.y));
                    w.z = cvt_pk_bf16(silu_f(v1[0]) * bf_lo(ov.z), silu_f(v1[1]) * bf_hi(ov.z));
                    w.w = cvt_pk_bf16(silu_f(v1[2]) * bf_lo(ov.w), silu_f(v1[3]) * bf_hi(ov.w));
                    if (STORE) *(u32x4*)(rowp + bj * HALF) = w; else asm volatile("" :: "v"(w)); } }
    }
};

typedef EpiGateT<true> EpiGate;
template <class Epi, class Sched, bool ALIGN_EPI = false, bool SP2 = false>
__device__ __forceinline__ void gemm_phase(PG8_LAS unsigned char* lds, const Gemm g, const Sched& S, const Epi& E) {
    int tid_ = threadIdx.x; asm volatile("" : "+v"(tid_));
    const int tid = tid_, wid = __builtin_amdgcn_readfirstlane(tid >> 6), lane = tid & 63, wr = wid >> 2, wc = wid & 3, fr = lane & 15, fq = lane >> 4;
    const int K = g.K, nt = K / BK;
    unsigned voffA[2], voffB[2];
#pragma unroll
    for (int i = 0; i < 2; ++i) { int R, C; stage_rc(tid * 16 + i * 8192, R, C); const int Rb = Epi::PERM ? ((R & ~31) + perm32(R & 31)) : R;
        voffA[i] = (unsigned)(R * K + C) * 2u; voffB[i] = (unsigned)(Rb * K + C) * 2u; }
    const size_t kstep = (size_t)(BK * 2);
    const size_t hstep = (size_t)HALF * K * 2;
    const size_t tstep = 2 * hstep;
    const unsigned ldsw = (unsigned)wid * 1024u;
    const int aoff = lds_byte(wr * 64 + fr, fq * 8), boff = lds_byte(wc * 32 + fr, fq * 8);
#define PG8_SA(b, h) (((b) * 2 + (h)) * HTB)
#define PG8_SB(b, h) ((4 + (b) * 2 + (h)) * HTB)
#define PG8_STAGE(bufoff, gbase, voff) do { _Pragma("unroll") for (int _i = 0; _i < 2; ++_i) \
        __builtin_amdgcn_global_load_lds((const unsigned*)((const char*)(gbase) + (voff)[_i]), (PG8_LAS unsigned*)(lds + (bufoff) + ldsw + _i * 8192), 16, 0, 0); } while (0)
#define PG8_LDA(dst, b, h) do { _Pragma("unroll") for (int m = 0; m < 4; ++m) _Pragma("unroll") for (int k = 0; k < 2; ++k) dst[m][k] = *(const PG8_LAS bf16x8*)(lds + PG8_SA(b, h) + aoff + m * 2048 + k * 1024); } while (0)
#define PG8_LDB(dst, b, h) do { _Pragma("unroll") for (int n = 0; n < 2; ++n) _Pragma("unroll") for (int k = 0; k < 2; ++k) dst[n][k] = *(const PG8_LAS bf16x8*)(lds + PG8_SB(b, h) + boff + n * 2048 + k * 1024); } while (0)
#define PG8_MMA(ai, bj, At, Bt) do { __builtin_amdgcn_s_setprio(1); _Pragma("unroll") for (int m = 0; m < 4; ++m) _Pragma("unroll") for (int n = 0; n < 2; ++n) _Pragma("unroll") for (int k = 0; k < 2; ++k) \
        acc[ai][bj][m][n] = __builtin_amdgcn_mfma_f32_16x16x32_bf16(Bt[n][k], At[m][k], acc[ai][bj][m][n], 0, 0, 0); __builtin_amdgcn_s_setprio(0); } while (0)
#define PG8_WAIT_V(n) asm volatile("s_waitcnt vmcnt(" #n ")" ::: "memory")
#define PG8_WAIT_L(n) asm volatile("s_waitcnt lgkmcnt(" #n ")" ::: "memory")
#define PG8_BAR __builtin_amdgcn_s_barrier()
#define PG8_SCHED __builtin_amdgcn_sched_barrier(0)
    Unit cur, nxt; int ui = 0;
    if (!S.next(0, cur)) return;
    f32x4 acc[2][2][4][2];
#pragma unroll
    for (int a = 0; a < 2; ++a)
#pragma unroll
        for (int b = 0; b < 2; ++b)
#pragma unroll
            for (int m = 0; m < 4; ++m)
#pragma unroll
                for (int n = 0; n < 2; ++n) acc[a][b][m][n] = (f32x4){0.f, 0.f, 0.f, 0.f};
    bf16x8 At[4][2], B0[2][2], B1[2][2];
    const char* cA = (const char*)g.A + (size_t)cur.pm * tstep; const char* cB = (const char*)g.Bt + (size_t)cur.pn * tstep;
    S.a_ready(cur);
    if constexpr (SP2) {
        PG8_STAGE(PG8_SB(0, 0), cB, voffB); PG8_STAGE(PG8_SB(0, 1), cB + hstep, voffB); PG8_STAGE(PG8_SA(0, 0), cA, voffA); PG8_STAGE(PG8_SA(0, 1), cA + hstep, voffA);
        if (wr == 1) PG8_BAR;
        PG8_WAIT_V(2); PG8_BAR;
        PG8_STAGE(PG8_SB(1, 0), cB + kstep, voffB); PG8_STAGE(PG8_SA(1, 0), cA + kstep, voffA); PG8_STAGE(PG8_SB(1, 1), cB + hstep + kstep, voffB);
        PG8_WAIT_V(6); PG8_BAR;
    } else {
        PG8_STAGE(PG8_SB(0, 0), cB, voffB); PG8_STAGE(PG8_SA(0, 0), cA, voffA); PG8_STAGE(PG8_SB(0, 1), cB + hstep, voffB); PG8_STAGE(PG8_SA(0, 1), cA + hstep, voffA);
        if (wr == 1) PG8_BAR;
        PG8_WAIT_V(4); PG8_BAR;
        PG8_STAGE(PG8_SB(1, 0), cB + kstep, voffB); PG8_STAGE(PG8_SA(1, 0), cA + kstep, voffA); PG8_STAGE(PG8_SB(1, 1), cB + hstep + kstep, voffB);
        PG8_WAIT_V(6); PG8_BAR;
    }
    for (;;) {
        const bool has_next = S.next(ui + 1, nxt);
        const char* nA = has_next ? (const char*)g.A + (size_t)nxt.pm * tstep : cA; const char* nB = has_next ? (const char*)g.Bt + (size_t)nxt.pn * tstep : cB;
        for (int t = 0; t < nt; t += 2) {
            const bool last = (t == nt - 2);
            const char* a1 = cA + (size_t)(t + 1) * kstep;
            const char* a2 = last ? nA : cA + (size_t)(t + 2) * kstep; const char* b2 = last ? nB : cB + (size_t)(t + 2) * kstep;
            const char* a3 = a2 + kstep; const char* b3 = b2 + kstep;
            if (last && has_next) S.a_ready(nxt);
            if constexpr (SP2) {
            PG8_LDB(B0, 0, 0); PG8_LDB(B1, 0, 1); PG8_SCHED; PG8_LDA(At, 0, 0); PG8_STAGE(PG8_SA(1, 1), a1 + hstep, voffA);
            PG8_WAIT_V(8); PG8_WAIT_L(0); PG8_BAR; PG8_MMA(0, 0, At, B0); PG8_MMA(0, 1, At, B1); PG8_BAR; PG8_SCHED;
            PG8_LDA(At, 0, 1); PG8_STAGE(PG8_SB(0, 0), b2, voffB); PG8_STAGE(PG8_SB(0, 1), b2 + hstep, voffB); PG8_STAGE(PG8_SA(0, 0), a2, voffA);
            PG8_WAIT_V(8); PG8_WAIT_L(0); PG8_BAR; PG8_MMA(1, 0, At, B0); PG8_MMA(1, 1, At, B1); PG8_BAR; PG8_SCHED;
            PG8_LDB(B0, 1, 0); PG8_LDB(B1, 1, 1); PG8_SCHED; PG8_LDA(At, 1, 0); PG8_STAGE(PG8_SA(0, 1), a2 + hstep, voffA);
            PG8_WAIT_V(8); PG8_WAIT_L(0); PG8_BAR; PG8_MMA(0, 0, At, B0); PG8_MMA(0, 1, At, B1); PG8_BAR; PG8_SCHED;
            PG8_LDA(At, 1, 1); PG8_STAGE(PG8_SB(1, 0), b3, voffB); PG8_STAGE(PG8_SB(1, 1), b3 + hstep, voffB); PG8_STAGE(PG8_SA(1, 0), a3, voffA);
            PG8_WAIT_V(8); PG8_WAIT_L(0); PG8_BAR; PG8_MMA(1, 0, At, B0); PG8_MMA(1, 1, At, B1); PG8_BAR; PG8_SCHED;
            } else {
            PG8_LDB(B0, 0, 0); PG8_SCHED; PG8_LDA(At, 0, 0); PG8_STAGE(PG8_SA(1, 1), a1 + hstep, voffA);
            PG8_WAIT_L(8); PG8_BAR; PG8_WAIT_L(0); PG8_MMA(0, 0, At, B0); PG8_BAR; PG8_SCHED;
            PG8_LDB(B1, 0, 1); PG8_STAGE(PG8_SB(0, 0), b2, voffB);
            PG8_BAR; PG8_WAIT_L(0); PG8_MMA(0, 1, At, B1); PG8_BAR;
            PG8_LDA(At, 0, 1); PG8_STAGE(PG8_SA(0, 0), a2, voffA);
            PG8_BAR; PG8_WAIT_L(0); PG8_MMA(1, 0, At, B0); PG8_BAR; PG8_SCHED;
            PG8_STAGE(PG8_SB(0, 1), b2 + hstep, voffB);
            PG8_WAIT_V(6); PG8_BAR; PG8_MMA(1, 1, At, B1); PG8_BAR;
            PG8_LDB(B0, 1, 0); PG8_SCHED; PG8_LDA(At, 1, 0); PG8_STAGE(PG8_SA(0, 1), a2 + hstep, voffA);
            PG8_WAIT_L(8); PG8_BAR; PG8_WAIT_L(0); PG8_MMA(0, 0, At, B0); PG8_BAR; PG8_SCHED;
            PG8_LDB(B1, 1, 1); PG8_STAGE(PG8_SB(1, 0), b3, voffB);
            PG8_BAR; PG8_WAIT_L(0); PG8_MMA(0, 1, At, B1); PG8_BAR;
            PG8_LDA(At, 1, 1); PG8_STAGE(PG8_SA(1, 0), a3, voffA);
            PG8_BAR; PG8_WAIT_L(0); PG8_MMA(1, 0, At, B0); PG8_BAR; PG8_SCHED;
            PG8_STAGE(PG8_SB(1, 1), b3 + hstep, voffB);
            PG8_WAIT_V(6); PG8_BAR; PG8_MMA(1, 1, At, B1); PG8_BAR;
            }
        }
        if constexpr (ALIGN_EPI) { if (wr == 0) PG8_BAR; }
        if constexpr (!Epi::AFTER_DRAIN) { E(acc, cur, wr, wc, fr, fq); S.done(cur); }
        if (!has_next) break;
#pragma unroll
        for (int a = 0; a < 2; ++a)
#pragma unroll
            for (int b = 0; b < 2; ++b)
#pragma unroll
                for (int m = 0; m < 4; ++m)
#pragma unroll
                    for (int n = 0; n < 2; ++n) acc[a][b][m][n] = (f32x4){0.f, 0.f, 0.f, 0.f};
        cur = nxt; cA = nA; cB = nB; ++ui;
        if constexpr (ALIGN_EPI) { if (wr == 1) PG8_BAR; }
    }
    PG8_WAIT_V(0);
    if constexpr (!ALIGN_EPI) { if (wr == 0) PG8_BAR; }
    PG8_BAR;
    if constexpr (Epi::AFTER_DRAIN) { E.fused(acc, cur, wr, wc, fr, fq, lds, wid, lane); S.done(cur); }
#undef PG8_SA
#undef PG8_SB
#undef PG8_STAGE
#undef PG8_LDA
#undef PG8_LDB
#undef PG8_MMA
#undef PG8_WAIT_V
#undef PG8_WAIT_L
#undef PG8_BAR
#undef PG8_SCHED
}
}

#define PG8_SP2 true
#define PG8_ALIGN true

constexpr int BATCH = 2, SEQ = 8192, DM = 1024, DI = 2048, MROWS = BATCH * SEQ;
constexpr int RH = 4, RDK = 256, RDV = 512, RCH = 128;
constexpr int RET_COLS = 6144;
constexpr int AH = 16, AD = 64, ADV = 128;
constexpr int DIFF_QKV_COLS = 6144, DIFF_COLS = 8192;
constexpr float RMS_EPS = 1e-6f, GN_EPS = 1e-5f;
constexpr float LOG2E = 1.4426950408889634f;
constexpr float LAMBDA_INIT = 0.35550906759096926f;
constexpr float QSCALE2 = 0.125f * LOG2E;
constexpr int NWAVES = 8, NTHREADS = 512;

constexpr size_t MiB = 1u << 20;
constexpr size_t WS_CTL = 0, CTL_ZERO_BYTES = 1 * MiB;
constexpr size_t WS_XCH = 2 * MiB;
constexpr size_t WS_W0IN = 4 * MiB;
constexpr size_t WS_W0OUT = 16 * MiB;
constexpr size_t WS_XN = 20 * MiB;
constexpr size_t WS_Q0 = 52 * MiB, WS_K0 = 84 * MiB, WS_V0 = 116 * MiB, WS_G0 = 180 * MiB;
constexpr size_t WS_Q1 = 52 * MiB, WS_K1 = 116 * MiB, WS_V1 = 180 * MiB;
constexpr size_t WS_YF_L0 = 52 * MiB;
constexpr size_t WS_YF_L1 = 116 * MiB;
constexpr size_t WS_W1G = 244 * MiB;
constexpr size_t WS_W1OUT = 248 * MiB;
constexpr size_t WS_END = 256 * MiB;
constexpr int CW_TMO = 0, CW_CODE = 1;
constexpr int CW_BAR = 4096;
constexpr int CW_SEAM = 16384, SEAM_BANK = 128 * 64;

typedef unsigned short bf16;
typedef unsigned v4u __attribute__((ext_vector_type(4)));
typedef float f32x4 __attribute__((ext_vector_type(4)));
#define GAS __attribute__((address_space(1)))
#define LAS __attribute__((address_space(3)))
typedef GAS unsigned gu32;
typedef GAS unsigned long long gu64;
#define RLX_AGENT __ATOMIC_RELAXED, __HIP_MEMORY_SCOPE_AGENT
#define LDS_WAIT() asm volatile("s_waitcnt lgkmcnt(0)" ::: "memory")
#define VM_WAIT() asm volatile("s_waitcnt vmcnt(0)" ::: "memory")

__device__ __forceinline__ unsigned f2bf(float f) { unsigned u = __builtin_bit_cast(unsigned, f); return (u + 0x7fffu + ((u >> 16) & 1u)) >> 16; }
__device__ __forceinline__ unsigned pk2(float lo, float hi) { return f2bf(lo) | (f2bf(hi) << 16); }
__device__ __forceinline__ float bf2f(bf16 h) { return __uint_as_float((unsigned)h << 16); }
using pg8::bf_lo; using pg8::bf_hi;
__device__ __forceinline__ float wave_sum(float v) {
#pragma unroll
    for (int o = 1; o < 64; o <<= 1) v += __shfl_xor(v, o);
    return v;
}

__device__ __forceinline__ void transpose_item(const float* W, int K, int N, bf16* WT, int n_lo, LAS float* scr, int item, int lane) {
    const int nblk = N / 32, kb = item / nblk, nb = item % nblk, k0 = 64 * kb, n0 = 32 * nb;
#pragma unroll 8
    for (int i = 0; i < 32; ++i) { const int kk = 2 * i + (lane >> 5); scr[kk * 33 + (lane & 31)] = W[(size_t)(k0 + kk) * N + n0 + (lane & 31)]; }
    LDS_WAIT(); asm volatile("" ::: "memory");
    const int c = lane & 7;
#pragma unroll
    for (int j = 0; j < 4; ++j) { const int n = (lane >> 3) + 8 * j; const LAS float* s = scr + (8 * c) * 33 + n;
        v4u o; o.x = pk2(s[0 * 33], s[1 * 33]); o.y = pk2(s[2 * 33], s[3 * 33]); o.z = pk2(s[4 * 33], s[5 * 33]); o.w = pk2(s[6 * 33], s[7 * 33]);
        *(v4u*)(WT + (size_t)(n0 + n - n_lo) * K + k0 + 8 * c) = o; }
    LDS_WAIT(); asm volatile("" ::: "memory");
}
__device__ __forceinline__ void transpose_all(const float* W, int K, int N, bf16* WT, int n_lo, int n_hi, LAS float* scr, int gw, int NGW, int lane) {
    const int nblk = N / 32, nsel = (n_hi - n_lo) / 32, nitems = (K / 64) * nsel;
    for (int it = gw; it < nitems; it += NGW) {
        const int kb = it / nsel, nb = it % nsel + n_lo / 32;
        transpose_item(W, K, N, WT, n_lo, scr, kb * nblk + nb, lane);
    }
}

__device__ __forceinline__ void norm_rows(const float* y, const float* base, const float* gpost, const float* gpre, float* out, bf16* xn, int mode, int gw, int NGW, int lane) {
    for (int m = gw; m < MROWS; m += NGW) {
        const f32x4* yr = (const f32x4*)(y + (size_t)m * DM) + lane;
        f32x4 v[4]; float s = 0.f;
#pragma unroll
        for (int j = 0; j < 4; ++j) { v[j] = yr[64 * j]; s += (v[j].x * v[j].x + v[j].y * v[j].y) + (v[j].z * v[j].z + v[j].w * v[j].w); }
        const float rstd = 1.0f / sqrtf(wave_sum(s) * (1.0f / DM) + RMS_EPS);
        if (mode == 0) {
            unsigned long long* o8 = (unsigned long long*)(xn + (size_t)m * DM) + lane;
#pragma unroll
            for (int j = 0; j < 4; ++j) { const f32x4 g = ((const f32x4*)gpre)[64 * j + lane];
                o8[64 * j] = (unsigned long long)pk2(v[j].x * rstd * g.x, v[j].y * rstd * g.y) | ((unsigned long long)pk2(v[j].z * rstd * g.z, v[j].w * rstd * g.w) << 32); }
        } else {
            const f32x4* br = (const f32x4*)(base + (size_t)m * DM) + lane; f32x4* orow = (f32x4*)(out + (size_t)m * DM) + lane;
            float s2 = 0.f;
#pragma unroll
            for (int j = 0; j < 4; ++j) { const f32x4 g = ((const f32x4*)gpost)[64 * j + lane]; const f32x4 b = br[64 * j];
                v[j] = b + v[j] * rstd * g; orow[64 * j] = v[j];
                s2 += (v[j].x * v[j].x + v[j].y * v[j].y) + (v[j].z * v[j].z + v[j].w * v[j].w); }
            if (mode == 1) {
                const float r2 = 1.0f / sqrtf(wave_sum(s2) * (1.0f / DM) + RMS_EPS);
                unsigned long long* o8 = (unsigned long long*)(xn + (size_t)m * DM) + lane;
#pragma unroll
                for (int j = 0; j < 4; ++j) { const f32x4 g = ((const f32x4*)gpre)[64 * j + lane];
                    o8[64 * j] = (unsigned long long)pk2(v[j].x * r2 * g.x, v[j].y * r2 * g.y) | ((unsigned long long)pk2(v[j].z * r2 * g.z, v[j].w * r2 * g.w) << 32); }
            }
        }
    }
}

__device__ __forceinline__ void gn_gate_rows(const bf16* RET, bf16* G, int gw, int NGW, int lane) {
    for (int it = gw; it < MROWS * RH; it += NGW) {
        const size_t off = (size_t)it * RDV + lane * 8;
        const v4u rv = *(const v4u*)(RET + off); const v4u gv = *(const v4u*)(G + off);
        float x[8] = {bf_lo(rv.x), bf_hi(rv.x), bf_lo(rv.y), bf_hi(rv.y), bf_lo(rv.z), bf_hi(rv.z), bf_lo(rv.w), bf_hi(rv.w)};
        float g[8] = {bf_lo(gv.x), bf_hi(gv.x), bf_lo(gv.y), bf_hi(gv.y), bf_lo(gv.z), bf_hi(gv.z), bf_lo(gv.w), bf_hi(gv.w)};
        float s = 0.f;
#pragma unroll
        for (int j = 0; j < 8; ++j) s += x[j];
        const float mu = wave_sum(s) * (1.0f / RDV);
        float q = 0.f;
#pragma unroll
        for (int j = 0; j < 8; ++j) { x[j] -= mu; q += x[j] * x[j]; }
        const float rstd = 1.0f / sqrtf(wave_sum(q) * (1.0f / RDV) + GN_EPS);
        v4u o; o.x = pk2(x[0] * rstd * g[0], x[1] * rstd * g[1]); o.y = pk2(x[2] * rstd * g[2], x[3] * rstd * g[3]);
        o.z = pk2(x[4] * rstd * g[4], x[5] * rstd * g[5]); o.w = pk2(x[6] * rstd * g[6], x[7] * rstd * g[7]);
        *(v4u*)(G + off) = o;
    }
}
__device__ __forceinline__ int t5_bucket(int n) {
    if (n < 16) return n;
    int l = 16 + (int)(logf((float)n / 16.0f) / 2.0794415416798357f * 16.0f);
    return l < 31 ? l : 31;
}
__device__ __forceinline__ float ret_lg(int h) { return log1pf(-exp2f(-5.0f - (float)h)); }
#define XB_TMO      128
#define XB_XCNT(j)  (256  + 64 * (j))
#define XB_XSUB(j)  (1280 + 64 * (j))
#define XB_XGEN(j)  (2304 + 64 * (j))
#define XB_TOP      3328
#define XB_TOPGEN   3392
#define XCD_BAR_WORDS 3456
#define XB_SPIN_CAP (1u << 26)

__device__ __forceinline__ unsigned xb_ld(unsigned* p)              { return __hip_atomic_load(p, __ATOMIC_RELAXED, __HIP_MEMORY_SCOPE_AGENT); }
__device__ __forceinline__ unsigned xb_add(unsigned* p, unsigned v) { return __hip_atomic_fetch_add(p, v, __ATOMIC_RELAXED, __HIP_MEMORY_SCOPE_AGENT); }
__device__ __forceinline__ unsigned xb_xcc_id() { return (unsigned)__builtin_amdgcn_s_getreg((3 << 11) | 20) & 0xFu; }
#define XB_SPIN(cond, bar) do { unsigned _sp = 0; while (cond) { __builtin_amdgcn_s_sleep(1); \
    if ((++_sp & 255u) == 0u) { if (xb_ld(&(bar)[XB_TMO])) break; if (_sp > XB_SPIN_CAP) { atomicAdd(&(bar)[XB_TMO], 1u); break; } } } } while (0)

struct XcdBarrier {
    unsigned* bar; unsigned x;
    volatile LAS unsigned* st;
};

__device__ __forceinline__ XcdBarrier xcd_barrier_post(unsigned* bar, volatile LAS unsigned* st) {
    XcdBarrier b; b.bar = bar; b.x = xb_xcc_id(); b.st = st;
    if (threadIdx.x == 0) (void)xb_add(&bar[XB_XCNT(b.x)], 1u);
    return b;
}
__device__ __forceinline__ void xcd_barrier_complete(unsigned* bar, unsigned x, unsigned& nloc, unsigned& nx) {
    const unsigned G = gridDim.x * gridDim.y * gridDim.z;
    unsigned sum, cnt, mine, sp = 0u;
    for (;;) {
        sum = 0u; cnt = 0u; mine = 0u;
#pragma unroll
        for (unsigned j = 0; j < 16; ++j) { const unsigned c = xb_ld(&bar[XB_XCNT(j)]); sum += c; cnt += (c > 0u) ? 1u : 0u; mine = (j == x) ? c : mine; }
        if (sum == G) break;
        __builtin_amdgcn_s_sleep(1);
        if ((++sp & 255u) == 0u) { if (xb_ld(&bar[XB_TMO])) break; if (sp > XB_SPIN_CAP) { atomicAdd(&bar[XB_TMO], 1u); break; } }
    }
    nloc = mine > 0u ? mine : 1u; nx = cnt > 0u ? cnt : 1u;
}

__device__ __forceinline__ void xcd_barrier(const XcdBarrier& b) {
    asm volatile("s_waitcnt vmcnt(0)" ::: "memory");
    __syncthreads();
    if (threadIdx.x == 0) {
        unsigned* bar = b.bar;
        __builtin_amdgcn_s_waitcnt(0);
        unsigned nloc = b.st[0], nx = b.st[1];
        if (nloc == 0u) { xcd_barrier_complete(bar, b.x, nloc, nx); b.st[0] = nloc; b.st[1] = nx; }
        const unsigned old = xb_add(&bar[XB_XSUB(b.x)], 1u);
        const unsigned gen = old / nloc;
        if (old + 1u == (gen + 1u) * nloc) {
            __builtin_amdgcn_fence(__ATOMIC_RELEASE, "agent");
            asm volatile("s_waitcnt vmcnt(0)" ::: "memory");
            const unsigned og = xb_add(&bar[XB_TOP], 1u);
            const unsigned tg = og / nx;
            if (og + 1u == (tg + 1u) * nx) xb_add(&bar[XB_TOPGEN], 1u);
            else XB_SPIN(xb_ld(&bar[XB_TOPGEN]) == tg, bar);
            __builtin_amdgcn_fence(__ATOMIC_ACQUIRE, "agent");
            xb_add(&bar[XB_XGEN(b.x)], 1u);
            asm volatile("s_waitcnt vmcnt(0)" ::: "memory");
        } else {
            XB_SPIN(xb_ld(&bar[XB_XGEN(b.x)]) == gen, bar);
            __builtin_amdgcn_fence(__ATOMIC_ACQUIRE, "agent");
            asm volatile("s_waitcnt vmcnt(0)" ::: "memory");
        }
    }
    __syncthreads();
}


__device__ __forceinline__ void nret_scores(const bf16* Q, const bf16* K, float* S, int n, int gtid, int NT) {
    for (int idx = gtid; idx < 8 * 128 * 128; idx += NT) {
        const int j = idx & 127, i = (idx >> 7) & 127, bh = idx >> 14, b = bh >> 2, h = bh & 3;
        const bf16* q = Q + (size_t)(b * SEQ + n * RCH + i) * 1024 + h * RDK;
        const bf16* k = K + (size_t)(b * SEQ + n * RCH + j) * 1024 + h * RDK;
        float s = 0.f;
        for (int d = 0; d < RDK; ++d) s += bf2f(q[d]) * bf2f(k[d]);
        S[idx] = s;
    }
}
__device__ __forceinline__ void nret_out(const bf16* Q, const bf16* V, const float* S, const float* R, bf16* RET, int n, int gtid, int NT) {
    for (int idx = gtid; idx < 8 * 128 * 512; idx += NT) {
        const int e = idx & 511, i = (idx >> 9) & 127, bh = idx >> 16, b = bh >> 2, h = bh & 3;
        const float lg = ret_lg(h);
        const float* Srow = S + ((size_t)bh * 128 + i) * 128;
        float acc = 0.f;
        for (int j = 0; j <= i; ++j) acc += expf(lg * (float)(i - j)) * Srow[j] * bf2f(V[(size_t)(b * SEQ + n * RCH + j) * 2048 + h * RDV + e]);
        const bf16* q = Q + (size_t)(b * SEQ + n * RCH + i) * 1024 + h * RDK;
        const float* Rb = R + (size_t)bh * RDK * RDV + e;
        float cr = 0.f;
        if (n > 0) for (int d = 0; d < RDK; ++d) cr += bf2f(q[d]) * Rb[(size_t)d * RDV];
        acc += expf(lg * (float)(i + 1)) * cr;
        RET[(size_t)(b * SEQ + n * RCH + i) * 2048 + h * RDV + e] = (bf16)f2bf(acc);
    }
}
__device__ __forceinline__ void nret_state(const bf16* K, const bf16* V, float* R, int n, int gtid, int NT) {
    for (int idx = gtid; idx < 8 * 256 * 512; idx += NT) {
        const int e = idx & 511, d = (idx >> 9) & 255, bh = idx >> 17, b = bh >> 2, h = bh & 3;
        const float lg = ret_lg(h);
        float acc = 0.f;
        for (int j = 0; j < RCH; ++j) acc += expf(lg * (float)(RCH - 1 - j)) * bf2f(K[(size_t)(b * SEQ + n * RCH + j) * 1024 + h * RDK + d]) * bf2f(V[(size_t)(b * SEQ + n * RCH + j) * 2048 + h * RDV + e]);
        R[idx] = (n == 0 ? 0.f : expf(lg * (float)RCH) * R[idx]) + acc;
    }
}

__device__ __forceinline__ void nattn_block(int blk, bf16* Q, const bf16* K, const bf16* V, float lam, const float* subln_g, const float* rel_bias,
                                            LAS float* o1s, LAS float* btab, int lane) {
    const int qb = blk & 127, bh = blk >> 7, b = bh >> 4, h = bh & 15;
    const int t = qb * 64 + lane;
    btab[lane] = rel_bias[t5_bucket(lane) * 16 + h] * LOG2E; btab[lane + 64] = rel_bias[t5_bucket(lane + 64) * 16 + h] * LOG2E;
    LDS_WAIT(); __builtin_amdgcn_wave_barrier();
    const int kmax = qb * 64 + 63;
    float ss = 0.f;
    for (int map = 0; map < 2; ++map) {
        float q[64];
        const v4u* qp = (const v4u*)(Q + (size_t)(b * SEQ + t) * 2048 + h * 128 + map * 64);
#pragma unroll
        for (int c = 0; c < 8; ++c) { const v4u w = qp[c]; q[8*c] = bf_lo(w.x); q[8*c+1] = bf_hi(w.x); q[8*c+2] = bf_lo(w.y); q[8*c+3] = bf_hi(w.y);
            q[8*c+4] = bf_lo(w.z); q[8*c+5] = bf_hi(w.z); q[8*c+6] = bf_lo(w.w); q[8*c+7] = bf_hi(w.w); }
        float mx = -INFINITY;
        for (int k = 0; k <= kmax; ++k) {
            const v4u* kp = (const v4u*)(K + (size_t)(b * SEQ + k) * 2048 + h * 128 + map * 64);
            float s = 0.f;
#pragma unroll
            for (int c = 0; c < 8; ++c) { const v4u w = kp[c];
                s += q[8*c] * bf_lo(w.x) + q[8*c+1] * bf_hi(w.x) + q[8*c+2] * bf_lo(w.y) + q[8*c+3] * bf_hi(w.y)
                   + q[8*c+4] * bf_lo(w.z) + q[8*c+5] * bf_hi(w.z) + q[8*c+6] * bf_lo(w.w) + q[8*c+7] * bf_hi(w.w); }
            const int dist = t - k;
            if (dist >= 0) { s += btab[dist < 127 ? dist : 127]; mx = fmaxf(mx, s); }
        }
        for (int half = 0; half < 2; ++half) {
            float o[64];
#pragma unroll
            for (int e = 0; e < 64; ++e) o[e] = 0.f;
            float l = 0.f;
            for (int k = 0; k <= kmax; ++k) {
                const v4u* kp = (const v4u*)(K + (size_t)(b * SEQ + k) * 2048 + h * 128 + map * 64);
                float s = 0.f;
#pragma unroll
                for (int c = 0; c < 8; ++c) { const v4u w = kp[c];
                    s += q[8*c] * bf_lo(w.x) + q[8*c+1] * bf_hi(w.x) + q[8*c+2] * bf_lo(w.y) + q[8*c+3] * bf_hi(w.y)
                       + q[8*c+4] * bf_lo(w.z) + q[8*c+5] * bf_hi(w.z) + q[8*c+6] * bf_lo(w.w) + q[8*c+7] * bf_hi(w.w); }
                const int dist = t - k;
                float p = 0.f;
                if (dist >= 0) { s += btab[dist < 127 ? dist : 127]; p = exp2f(s - mx); }
                l += p;
                const v4u* vp = (const v4u*)(V + (size_t)(b * SEQ + k) * 2048 + h * 128 + half * 64);
#pragma unroll
                for (int c = 0; c < 8; ++c) { const v4u w = vp[c];
                    o[8*c] += p * bf_lo(w.x); o[8*c+1] += p * bf_hi(w.x); o[8*c+2] += p * bf_lo(w.y); o[8*c+3] += p * bf_hi(w.y);
                    o[8*c+4] += p * bf_lo(w.z); o[8*c+5] += p * bf_hi(w.z); o[8*c+6] += p * bf_lo(w.w); o[8*c+7] += p * bf_hi(w.w); }
            }
            const float linv = 1.0f / l;
            if (map == 0) {
#pragma unroll
                for (int e = 0; e < 64; ++e) o1s[(half * 64 + e) * 64 + lane] = o[e] * linv;
            } else {
#pragma unroll
                for (int e = 0; e < 64; ++e) { const float d = o1s[(half * 64 + e) * 64 + lane] - lam * (o[e] * linv); ss += d * d; o1s[(half * 64 + e) * 64 + lane] = d; }
            }
        }
    }
    {
        const float r = 1.0f / sqrtf(ss * (1.0f / 128.0f) + GN_EPS) * (1.0f - LAMBDA_INIT);
        bf16* op = Q + (size_t)(b * SEQ + t) * 2048 + h * 128;
#pragma unroll 8
        for (int e = 0; e < 128; e += 2) *(unsigned*)(op + e) = pk2(o1s[e * 64 + lane] * r * subln_g[e], o1s[(e + 1) * 64 + lane] * r * subln_g[e + 1]);
    }
    LDS_WAIT(); __builtin_amdgcn_wave_barrier();
}
__device__ __forceinline__ float diff_lambda(const float* lq1, const float* lk1, const float* lq2, const float* lk2) {
    float d1 = 0.f, d2 = 0.f;
    for (int i = 0; i < 64; ++i) { d1 += lq1[i] * lk1[i]; d2 += lq2[i] * lk2[i]; }
    return expf(d1) - expf(d2) + LAMBDA_INIT;
}

namespace da {
using bf16x8 = __attribute__((ext_vector_type(8))) short;
using s16x4 = __attribute__((ext_vector_type(4))) short;
using f32x16 = __attribute__((ext_vector_type(16))) float;
using u32x4 = __attribute__((ext_vector_type(4))) unsigned;
typedef short v4i16_t __attribute__((ext_vector_type(4)));
typedef LAS const char* lds_cptr;
constexpr int PITCH = 2048, KVB = 64, SLOT = 32768, OFF_K0 = 0, OFF_K1 = 8192, OFF_V = 16384;
constexpr int LDS_WS = 98304;
constexpr int LDS_BT = 100352;
constexpr int LDS_X = 0;
constexpr int LDS_OST = 65536;
constexpr float THR = 8.0f;
#define DA_SBAR() __builtin_amdgcn_sched_barrier(0)
#define DA_MFMA(a, b, c) __builtin_amdgcn_mfma_f32_32x32x16_bf16(a, b, c, 0, 0, 0)
#define DA_WAIT_BAR(N) asm volatile("s_waitcnt vmcnt(" #N ") lgkmcnt(0)\n\ts_barrier" ::: "memory")
__device__ __forceinline__ int crow(int r, int hi) { return (r & 3) + 8 * (r >> 2) + 4 * hi; }
__device__ __forceinline__ void glds16(const void* gsrc, unsigned lds_dst) { unsigned keep;
    asm volatile("s_mov_b32 %0, m0\n\ts_mov_b32 m0, %2\n\ts_nop 0\n\tglobal_load_lds_dwordx4 %1, off\n\ts_mov_b32 m0, %0" : "=&s"(keep) : "v"(gsrc), "s"(lds_dst) : "memory"); }
__device__ __forceinline__ s16x4 vtr(lds_cptr p) { return __builtin_bit_cast(s16x4, __builtin_amdgcn_ds_read_tr16_b64_v4i16((LAS v4i16_t*)p)); }
__device__ __forceinline__ unsigned cvtpk(float lo, float hi) { typedef float f2 __attribute__((ext_vector_type(2))); typedef __bf16 b2 __attribute__((ext_vector_type(2)));
    f2 v = {lo, hi}; b2 b = __builtin_convertvector(v, b2); return __builtin_bit_cast(unsigned, b); }
#define DA_MX3(a, b, c) __builtin_fmaxf(__builtin_fmaxf((a), (b)), (c))
__device__ __forceinline__ float rowmax(const f32x16& p0, const f32x16& p1) {
    float a = DA_MX3(p0[0], p0[1], p1[0]), b = DA_MX3(p0[2], p0[3], p1[1]); a = DA_MX3(a, p1[2], p1[3]);
#pragma unroll
    for (int r = 4; r < 16; r += 4) { a = DA_MX3(a, p0[r], p0[r + 1]); b = DA_MX3(b, p0[r + 2], p0[r + 3]); a = DA_MX3(a, p1[r], p1[r + 1]); b = DA_MX3(b, p1[r + 2], p1[r + 3]); }
    float m = __builtin_fmaxf(a, b); auto rr = __builtin_amdgcn_permlane32_swap(__float_as_uint(m), __float_as_uint(m), false, false);
    return __builtin_fmaxf(__uint_as_float(rr[0]), __uint_as_float(rr[1])); }

template <bool STORE, int MODE = 0> __device__ __forceinline__ void attn_unit(int b, int h, int qb, bf16* Q, const bf16* K, const bf16* V, float lam, const float* subln_g, LAS char* shm) {
    int tid_ = threadIdx.x; asm volatile("" : "+v"(tid_));
    const int tid = tid_, lane = tid & 63, r32 = lane & 31, hi = lane >> 5; const int wid = __builtin_amdgcn_readfirstlane(tid >> 6);
    const int map = wid >> 2, qblk = wid & 3;
    const long rowbase = (long)b * SEQ; const int q0 = qb * 128; const int NT = 2 * qb + 2;
    const bf16* Qw = Q + (rowbase + q0 + qblk * 32) * PITCH + h * 128 + map * 64;
    const bf16* Kh = K + rowbase * PITCH + h * 128; const bf16* Vh = V + rowbase * PITCH + h * 128;
    const unsigned lds0 = (unsigned)(uintptr_t)shm;
    LAS float* wsf = (LAS float*)(shm + LDS_WS) + wid * 64;
    const LAS float* btab = (const LAS float*)(shm + LDS_BT);
    const bf16* ksrc = Kh + (long)lane * PITCH + wid * 8;
    const bf16* vsrc = Vh + (long)(16 * (wid & 3) + (lane >> 2)) * PITCH + (wid >> 2) * 32 + (lane & 3) * 8;
    const unsigned kdst = lds0 + OFF_K0 + wid * 1024, vdst = lds0 + OFF_V + wid * 1024;
#define DA_DMA_PIECE(i, t, slot) do { if (MODE >= 2) break; const long go_ = (long)(t) * KVB * PITCH; const unsigned so_ = (unsigned)(slot); \
        if ((i) == 0) glds16(ksrc + go_, (unsigned)__builtin_amdgcn_readfirstlane(kdst + so_)); \
        if ((i) == 1) glds16(ksrc + go_ + 64, (unsigned)__builtin_amdgcn_readfirstlane(kdst + so_ + 8192)); \
        if ((i) == 2) glds16(vsrc + go_, (unsigned)__builtin_amdgcn_readfirstlane(vdst + so_)); \
        if ((i) == 3) glds16(vsrc + go_ + 64, (unsigned)__builtin_amdgcn_readfirstlane(vdst + so_ + 8192)); } while (0)
#define DA_DMA(t, slot) do { DA_DMA_PIECE(0, t, slot); DA_DMA_PIECE(1, t, slot); DA_DMA_PIECE(2, t, slot); DA_DMA_PIECE(3, t, slot); } while (0)
    const lds_cptr kp0 = (lds_cptr)shm + (map ? OFF_K1 : OFF_K0) + hi * 1024 + r32 * 16;
    const lds_cptr vp0 = (lds_cptr)shm + OFF_V + ((lane >> 4) & 1) * 32 + (lane & 3) * 8 + (4 * hi + ((lane & 15) >> 2)) * 64;
    DA_DMA(0, 0); DA_DMA(1, SLOT);
    bf16x8 qr[4];
#pragma unroll
    for (int d0 = 0; d0 < 4; ++d0) qr[d0] = *reinterpret_cast<const bf16x8*>(&Qw[(long)r32 * PITCH + d0 * 16 + hi * 8]);
    float mhat = 0.f, l_reg = 0.f;
    f32x16 o[4];
#pragma unroll
    for (int g = 0; g < 4; ++g) o[g] = f32x16{};
    f32x16 negm = f32x16{}; asm volatile("" : "+v"(negm));
    const int qpos = q0 + qblk * 32 + r32;
#pragma unroll
    for (int d0 = 0; d0 < 4; ++d0) asm volatile("" : "+v"(qr[d0]));
    int slot = 0;
#define DA_VLOAD(dst, g_) do { _Pragma("unroll") for (int ks_ = 0; ks_ < 4; ++ks_) { const s16x4 lo_ = vtr(vp + (g_) * 4096 + ks_ * 1024), hh_ = vtr(vp + (g_) * 4096 + ks_ * 1024 + 512); \
        dst[ks_] = (bf16x8){lo_[0], lo_[1], lo_[2], lo_[3], hh_[0], hh_[1], hh_[2], hh_[3]}; } } while (0)
#pragma unroll 1
    for (int t = 0; t < NT; ++t) {
        if (t + 1 < NT) { DA_WAIT_BAR(4); } else { DA_WAIT_BAR(0); }
        const int s2 = (slot >= SLOT) ? slot - SLOT : slot + 2 * SLOT; const bool dma2 = t + 2 < NT;
        const lds_cptr kp = kp0 + slot; const lds_cptr vp = vp0 + slot;
        f32x16 c0, c1;
        {
            bf16x8 kf[8];
#pragma unroll
            for (int j = 0; j < 4; ++j) { kf[2 * j] = *(const LAS bf16x8*)(kp + j * 2048); kf[2 * j + 1] = *(const LAS bf16x8*)(kp + j * 2048 + 512); }
            c0 = DA_MFMA(kf[0], qr[0], negm); c1 = DA_MFMA(kf[1], qr[0], negm);
            c0 = DA_MFMA(kf[2], qr[1], c0); c1 = DA_MFMA(kf[3], qr[1], c1);
            c0 = DA_MFMA(kf[4], qr[2], c0); c1 = DA_MFMA(kf[5], qr[2], c1);
            c0 = DA_MFMA(kf[6], qr[3], c0); c1 = DA_MFMA(kf[7], qr[3], c1);
        }
        DA_SBAR();
        bf16x8 va[4], vb[4];
        DA_VLOAD(va, 0); DA_VLOAD(vb, 1);
        DA_SBAR();
        if (t * KVB + 63 + 113 > q0 + qblk * 32) {
            const int kb = t * KVB + 4 * hi;
#pragma unroll
            for (int r = 0; r < 16; ++r) {
                const int d0 = qpos - (kb + (r & 3) + 8 * (r >> 2)); const int d1 = d0 - 32;
                c0[r] += btab[(d0 < 127 ? d0 : 127) + 127];
                c1[r] += btab[(d1 < 127 ? d1 : 127) + 127];
            }
        }
        {
            const float rm = rowmax(c0, c1);
            if (__any(rm > THR)) {
                const float dl = __builtin_fmaxf(rm, 0.f); mhat += dl;
#pragma unroll
                for (int r = 0; r < 16; ++r) { c0[r] -= dl; c1[r] -= dl; }
#pragma unroll
                for (int r = 0; r < 16; ++r) negm[r] = -mhat;
                asm volatile("" : "+v"(negm));
                const float f = __builtin_amdgcn_exp2f(-dl); l_reg *= f;
                if (hi == 0) wsf[r32] = f;
                asm volatile("s_waitcnt lgkmcnt(0)" ::: "memory");
#pragma unroll
                for (int r = 0; r < 16; ++r) { const float fr = wsf[crow(r, hi)];
#pragma unroll
                    for (int g = 0; g < 4; ++g) o[g][r] *= fr; }
            }
        }
#pragma unroll
        for (int r = 0; r < 16; ++r) { c0[r] = __builtin_amdgcn_exp2f(c0[r]); c1[r] = __builtin_amdgcn_exp2f(c1[r]); }
        bf16x8 pa[4];
        {
            u32x4 w0 = {cvtpk(c0[0], c0[1]), cvtpk(c0[2], c0[3]), cvtpk(c0[4], c0[5]), cvtpk(c0[6], c0[7])};
            u32x4 w1 = {cvtpk(c0[8], c0[9]), cvtpk(c0[10], c0[11]), cvtpk(c0[12], c0[13]), cvtpk(c0[14], c0[15])};
            u32x4 w2 = {cvtpk(c1[0], c1[1]), cvtpk(c1[2], c1[3]), cvtpk(c1[4], c1[5]), cvtpk(c1[6], c1[7])};
            u32x4 w3 = {cvtpk(c1[8], c1[9]), cvtpk(c1[10], c1[11]), cvtpk(c1[12], c1[13]), cvtpk(c1[14], c1[15])};
            pa[0] = __builtin_bit_cast(bf16x8, w0); pa[1] = __builtin_bit_cast(bf16x8, w1); pa[2] = __builtin_bit_cast(bf16x8, w2); pa[3] = __builtin_bit_cast(bf16x8, w3);
        }
        DA_SBAR();
        float sacc = 0.f;
#define DA_GAP(g_, ks_, VF) do { o[g_] = DA_MFMA(pa[ks_], VF[ks_], o[g_]); { const int r_ = (g_) * 4 + (ks_); sacc += c0[r_]; sacc += c1[r_]; asm volatile("" : "+v"(sacc)); } DA_SBAR(); } while (0)
        bf16x8 vc[4], vd[4];
        DA_VLOAD(vc, 2);
        DA_SBAR();
        DA_GAP(0, 0, va); DA_GAP(0, 1, va); DA_GAP(0, 2, va); DA_GAP(0, 3, va);
        if (dma2) DA_DMA_PIECE(0, t + 2, s2);
        DA_VLOAD(vd, 3);
        DA_SBAR();
        DA_GAP(1, 0, vb); DA_GAP(1, 1, vb); DA_GAP(1, 2, vb); DA_GAP(1, 3, vb);
        if (dma2) DA_DMA_PIECE(1, t + 2, s2);
        DA_SBAR();
        DA_GAP(2, 0, vc); DA_GAP(2, 1, vc); DA_GAP(2, 2, vc); DA_GAP(2, 3, vc);
        if (dma2) DA_DMA_PIECE(2, t + 2, s2);
        DA_SBAR();
        DA_GAP(3, 0, vd); DA_GAP(3, 1, vd); DA_GAP(3, 2, vd); DA_GAP(3, 3, vd);
        if (dma2) DA_DMA_PIECE(3, t + 2, s2);
        l_reg += sacc;
#undef DA_GAP
        slot = (slot == 2 * SLOT) ? 0 : slot + SLOT;
    }
#undef DA_VLOAD
    asm volatile("s_waitcnt vmcnt(0) lgkmcnt(0)\n\ts_barrier" ::: "memory");
    { auto rr = __builtin_amdgcn_permlane32_swap(__float_as_uint(l_reg), __float_as_uint(l_reg), false, false); l_reg = __uint_as_float(rr[0]) + __uint_as_float(rr[1]); }
    if (hi == 0) wsf[32 + r32] = l_reg;
    asm volatile("s_waitcnt lgkmcnt(0)" ::: "memory");
    float rli[16];
#pragma unroll
    for (int r = 0; r < 16; ++r) rli[r] = __builtin_amdgcn_rcpf(wsf[32 + crow(r, hi)]);
    LAS float* X = (LAS float*)(shm + LDS_X);
    if (map == 1) {
#pragma unroll
        for (int r = 0; r < 16; ++r)
#pragma unroll
            for (int g = 0; g < 4; ++g) X[(((wid - 4) * 16 + r) * 4 + g) * 64 + lane] = o[g][r] * rli[r];
    }
    asm volatile("s_waitcnt lgkmcnt(0)\n\ts_barrier" ::: "memory");
    if (map == 0) {
        float ss[16];
#pragma unroll
        for (int r = 0; r < 16; ++r) { float s = 0.f;
#pragma unroll
            for (int g = 0; g < 4; ++g) { const float d = o[g][r] * rli[r] - lam * X[((wid * 16 + r) * 4 + g) * 64 + lane]; o[g][r] = d; s += d * d; }
            ss[r] = s; }
#pragma unroll
        for (int r = 0; r < 16; ++r) { float s = ss[r];
            s += __shfl_xor(s, 1); s += __shfl_xor(s, 2); s += __shfl_xor(s, 4); s += __shfl_xor(s, 8); s += __shfl_xor(s, 16);
            ss[r] = (1.0f / sqrtf(s * (1.0f / 128.0f) + GN_EPS)) * (1.0f - LAMBDA_INIT); }
        float gsub[4];
#pragma unroll
        for (int g = 0; g < 4; ++g) gsub[g] = subln_g[32 * g + r32];
        LAS bf16* stg = (LAS bf16*)(shm + LDS_OST) + wid * 4096;
#pragma unroll
        for (int r = 0; r < 16; ++r) { const int orow = crow(r, hi);
#pragma unroll
            for (int g = 0; g < 4; ++g) stg[orow * 128 + 32 * g + r32] = (bf16)f2bf(o[g][r] * ss[r] * gsub[g]); }
        asm volatile("s_waitcnt lgkmcnt(0)" ::: "memory");
        bf16* Ow = Q + (rowbase + q0 + qblk * 32) * PITCH + h * 128;
#pragma unroll
        for (int i = 0; i < 8; ++i) { const int row = i * 4 + (lane >> 4), ch = lane & 15;
            const u32x4 v = *(const LAS u32x4*)(stg + row * 128 + ch * 8);
            if (STORE) *(u32x4*)(Ow + (long)row * PITCH + ch * 8) = v; else asm volatile("" :: "v"(v)); }
    }
    asm volatile("s_waitcnt vmcnt(0) lgkmcnt(0)\n\ts_barrier" ::: "memory");
#undef DA_DMA
#undef DA_DMA_PIECE
}

template <bool STORE, int MODE = 0> __device__ __forceinline__ void attn_phase(LAS char* shm, bf16* Q, const bf16* K, const bf16* V, const float* lq1, const float* lk1, const float* lq2, const float* lk2,
                                           const float* subln_g, const float* rel_bias, int vcu, int G) {
    const float lam = diff_lambda(lq1, lk1, lq2, lk2);
    const int tid = threadIdx.x;
    for (int bh = vcu >> 3; bh < BATCH * AH; bh += (G >> 3)) {
        const int b = bh >> 4, h = bh & 15, s = vcu & 7;
        if (tid < 255) ((LAS float*)(shm + LDS_BT))[tid] = tid < 127 ? -INFINITY : (rel_bias[t5_bucket(tid - 127) * 16 + h] - rel_bias[31 * 16 + h]) * LOG2E;
        asm volatile("s_waitcnt lgkmcnt(0)\n\ts_barrier" ::: "memory");
#pragma unroll 1
        for (int i = 0; i < 8; ++i) {
            const int base = (i >> 1) * 16; const int qb = (i & 1) ? base + 15 - s : base + s;
            attn_unit<STORE, MODE>(b, h, qb, Q, K, V, lam, subln_g, shm);
        }
    }
}
#undef DA_SBAR
#undef DA_MFMA
#undef DA_WAIT_BAR
#undef DA_MX3
}

namespace rt {
using bf16x8 = __attribute__((ext_vector_type(8))) short;
using s16x4 = __attribute__((ext_vector_type(4))) short;
using f32x4v = __attribute__((ext_vector_type(4))) float;
using u32x4 = __attribute__((ext_vector_type(4))) unsigned;
constexpr int QS = 264, KS = 264, KT = 72, VT = 72, SS = 72;
constexpr int OFF_Q = 0, OFF_K = OFF_Q + 64 * QS * 2, OFF_KT = OFF_K + 64 * KS * 2, OFF_VT = OFF_KT + 256 * KT * 2, OFF_S = OFF_VT + 128 * VT * 2, LDS_END = OFF_S + 64 * SS * 2;
#define RT_MFMA(a, b, c) __builtin_amdgcn_mfma_f32_16x16x32_bf16(a, b, c, 0, 0, 0)

template <bool FULL, bool STORE> __device__ __forceinline__ void ret_unit(int unit, const bf16* Q, const bf16* K, bf16* V, float* E, LAS char* shm) {
    int tid_ = threadIdx.x; asm volatile("" : "+v"(tid_));
    const int tid = tid_, lane = tid & 63, c = lane & 15, g = lane >> 4; const int wid = __builtin_amdgcn_readfirstlane(tid >> 6);
    const int seg = unit & 7, dvs = (unit >> 3) & 3, bh = unit >> 5, b = bh >> 2, h = bh & 3;
    if (!FULL && seg == 7) return;
    const float lg2 = __builtin_amdgcn_logf(1.0f - __builtin_amdgcn_exp2f(-5.0f - (float)h));
    const float d64 = __builtin_amdgcn_exp2f(64.0f * lg2), d1024 = __builtin_amdgcn_exp2f(1024.0f * lg2);
    const size_t tok0 = (size_t)b * SEQ + (size_t)seg * 1024;
    const bf16* Qg = Q + tok0 * 1024 + h * 256; const bf16* Kg = K + tok0 * 1024 + h * 256;
    bf16* Vg = V + tok0 * 2048 + h * 512 + dvs * 128;
    LAS bf16* Qs = (LAS bf16*)(shm + OFF_Q); LAS bf16* Ks = (LAS bf16*)(shm + OFF_K); LAS bf16* KTs = (LAS bf16*)(shm + OFF_KT);
    LAS bf16* VTs = (LAS bf16*)(shm + OFF_VT); LAS bf16* Ss = (LAS bf16*)(shm + OFF_S);
    f32x4v R[16];
#pragma unroll
    for (int kt = 0; kt < 16; ++kt) R[kt] = (f32x4v){0.f, 0.f, 0.f, 0.f};
    if (FULL) {
        for (int j = 0; j < seg; ++j) {
            const float* Ej = E + ((size_t)(unit - seg + j) * 8 + wid) * 4096 + lane;
#pragma unroll
            for (int kt = 0; kt < 16; ++kt)
#pragma unroll
                for (int r = 0; r < 4; ++r) R[kt][r] = d1024 * R[kt][r] + Ej[(kt * 4 + r) * 64];
        }
    }
    u32x4 pq[4], pk[4], pv[2];
#define RT_LOAD(step) do { \
        if (FULL) { _Pragma("unroll") for (int it = 0; it < 4; ++it) pq[it] = *(const u32x4*)(Qg + (size_t)((step) * 64 + (tid >> 5) + 16 * it) * 1024 + (tid & 31) * 8); } \
        _Pragma("unroll") for (int it = 0; it < 4; ++it) pk[it] = *(const u32x4*)(Kg + (size_t)((step) * 64 + lane) * 1024 + (wid * 4 + it) * 8); \
        _Pragma("unroll") for (int it = 0; it < 2; ++it) pv[it] = *(const u32x4*)(Vg + (size_t)((step) * 64 + lane) * 2048 + (wid * 2 + it) * 8); } while (0)
#define RT_STORE() do { \
        if (FULL) { _Pragma("unroll") for (int it = 0; it < 4; ++it) *(LAS u32x4*)(Qs + ((tid >> 5) + 16 * it) * QS + (tid & 31) * 8) = pq[it]; \
                    _Pragma("unroll") for (int it = 0; it < 4; ++it) *(LAS u32x4*)(Ks + lane * KS + (wid * 4 + it) * 8) = pk[it]; } \
        _Pragma("unroll") for (int it = 0; it < 4; ++it) { const int d0_ = (wid * 4 + it) * 8; \
            _Pragma("unroll") for (int w_ = 0; w_ < 4; ++w_) { const unsigned x_ = pk[it][w_]; KTs[(d0_ + 2 * w_) * KT + lane] = (bf16)(x_ & 0xffffu); KTs[(d0_ + 2 * w_ + 1) * KT + lane] = (bf16)(x_ >> 16); } } \
        _Pragma("unroll") for (int it = 0; it < 2; ++it) { const int d0_ = (wid * 2 + it) * 8; \
            _Pragma("unroll") for (int w_ = 0; w_ < 4; ++w_) { const unsigned x_ = pv[it][w_]; VTs[(d0_ + 2 * w_) * VT + lane] = (bf16)(x_ & 0xffffu); VTs[(d0_ + 2 * w_ + 1) * VT + lane] = (bf16)(x_ >> 16); } } } while (0)
    RT_LOAD(0);
    RT_STORE();
#pragma unroll 1
    for (int step = 0; step < 16; ++step) {
        __syncthreads();
        if (step + 1 < 16) RT_LOAD(step + 1);
        if (FULL) {
            const int qt_s = wid >> 1;
#pragma unroll
            for (int u = 0; u < 2; ++u) {
                const int kt2 = 2 * (wid & 1) + u;
                f32x4v s = (f32x4v){0.f, 0.f, 0.f, 0.f};
                if (kt2 <= qt_s) {
#pragma unroll
                    for (int kk = 0; kk < 8; ++kk) {
                        const bf16x8 a = *(const LAS bf16x8*)(Qs + (16 * qt_s + c) * QS + kk * 32 + 8 * g);
                        const bf16x8 bb = *(const LAS bf16x8*)(Ks + (16 * kt2 + c) * KS + kk * 32 + 8 * g);
                        s = RT_MFMA(a, bb, s);
                        if (kk & 1) __builtin_amdgcn_sched_barrier(0);
                    }
                    if (kt2 == qt_s) {
#pragma unroll
                        for (int r = 0; r < 4; ++r) if (c > 4 * g + r) s[r] = 0.f;
                    }
                }
#pragma unroll
                for (int r = 0; r < 4; ++r) Ss[(16 * qt_s + 4 * g + r) * SS + 16 * kt2 + c] = (bf16)f2bf(s[r]);
            }
            f32x4v RT[4];
#pragma unroll
            for (int qt = 0; qt < 4; ++qt) RT[qt] = (f32x4v){0.f, 0.f, 0.f, 0.f};
#pragma unroll
            for (int kb = 0; kb < 8; ++kb) {
                u32x4 bw; bw.x = pg8::cvt_pk_bf16(R[2 * kb][0], R[2 * kb][1]); bw.y = pg8::cvt_pk_bf16(R[2 * kb][2], R[2 * kb][3]);
                bw.z = pg8::cvt_pk_bf16(R[2 * kb + 1][0], R[2 * kb + 1][1]); bw.w = pg8::cvt_pk_bf16(R[2 * kb + 1][2], R[2 * kb + 1][3]);
                const bf16x8 bb = __builtin_bit_cast(bf16x8, bw);
#pragma unroll
                for (int qt = 0; qt < 4; ++qt) {
                    const s16x4 lo = *(const LAS s16x4*)(Qs + (16 * qt + c) * QS + 32 * kb + 4 * g);
                    const s16x4 hh = *(const LAS s16x4*)(Qs + (16 * qt + c) * QS + 32 * kb + 16 + 4 * g);
                    const bf16x8 a = {lo[0], lo[1], lo[2], lo[3], hh[0], hh[1], hh[2], hh[3]};
                    RT[qt] = RT_MFMA(a, bb, RT[qt]);
                }
                __builtin_amdgcn_sched_barrier(0);
            }
            __syncthreads();
#pragma unroll
            for (int kk = 0; kk < 2; ++kk) {
                const bf16x8 bb = *(const LAS bf16x8*)(VTs + (16 * wid + c) * VT + kk * 32 + 8 * g);
#pragma unroll
                for (int qt = 0; qt < 4; ++qt) {
                    const bf16x8 a = *(const LAS bf16x8*)(Ss + (16 * qt + c) * SS + kk * 32 + 8 * g);
                    RT[qt] = RT_MFMA(a, bb, RT[qt]);
                }
            }
#pragma unroll
            for (int qt = 0; qt < 4; ++qt)
#pragma unroll
                for (int r = 0; r < 4; ++r) { if (STORE) Vg[(size_t)(step * 64 + 16 * qt + 4 * g + r) * 2048 + 16 * wid + c] = (bf16)f2bf(RT[qt][r]); else asm volatile("" :: "v"(RT[qt][r])); }
        }
#pragma unroll
        for (int kk = 0; kk < 2; ++kk) {
            const bf16x8 bb = *(const LAS bf16x8*)(VTs + (16 * wid + c) * VT + kk * 32 + 8 * g);
#pragma unroll
            for (int kt = 0; kt < 16; ++kt) {
                const bf16x8 a = *(const LAS bf16x8*)(KTs + (16 * kt + c) * KT + kk * 32 + 8 * g);
                R[kt] = RT_MFMA(a, bb, R[kt]);
                if ((kt & 3) == 3) __builtin_amdgcn_sched_barrier(0);
            }
        }
#pragma unroll
        for (int kt = 0; kt < 16; ++kt) R[kt] = R[kt] * d64;
        __syncthreads();
        if (step + 1 < 16) RT_STORE();
    }
    if (!FULL) {
        float* Eu = E + ((size_t)unit * 8 + wid) * 4096 + lane;
#pragma unroll
        for (int kt = 0; kt < 16; ++kt)
#pragma unroll
            for (int r = 0; r < 4; ++r) Eu[(kt * 4 + r) * 64] = R[kt][r];
    }
    __syncthreads();
#undef RT_LOAD
#undef RT_STORE
}
#undef RT_MFMA
}

constexpr int RING_OFF = 0, RING_BYTES = 143360;
constexpr int LDSCTL_OFF = RING_BYTES, MISC_OFF = LDSCTL_OFF + 320;
constexpr int LDS_BYTES = 147456;

#ifndef PROBE_ATT
#define PROBE_ATT 0
#endif
#ifndef PROBE_ATT_MODE
#define PROBE_ATT_MODE 0
#endif
#ifndef PROBE_RET
#define PROBE_RET 0
#endif
#ifndef PROBE_GEMM
#define PROBE_GEMM 0
#endif
#ifndef PROBE_MISC
#define PROBE_MISC 0
#endif
struct Frame {
    LAS unsigned char* lds;
    volatile LAS unsigned* MISC;
    gu32* ctl;
    int tid, lane, wave;
    int vcu, G;
};

struct Args { const float* in[13]; float* out; unsigned char* ws; int ph_lo, ph_hi; };

__global__ void __launch_bounds__(NTHREADS, 2) mega_fwd(Args args) {
    extern __shared__ __attribute__((aligned(16))) unsigned char lds[];
    Frame F;
    F.lds = (LAS unsigned char*)lds;
    F.MISC = (volatile LAS unsigned*)(F.lds + MISC_OFF);
    F.tid = threadIdx.x; F.lane = F.tid & 63; F.wave = __builtin_amdgcn_readfirstlane(F.tid >> 6);
    F.G = gridDim.x; { const int bx = blockIdx.x; F.vcu = (F.G % 8 == 0) ? (bx % 8) * (F.G / 8) + bx / 8 : bx; }
    unsigned char* ws = args.ws;
    F.ctl = (gu32*)(ws + WS_CTL);
    const float* x = args.in[0]; const float* pre_g = args.in[1]; const float* post_g = args.in[2];
    const float* ret_w_in = args.in[3]; const float* ret_w_out = args.in[4];
    const float* diff_w_in = args.in[5]; const float* diff_w_out = args.in[6];
    const float* lq1 = args.in[7]; const float* lk1 = args.in[8]; const float* lq2 = args.in[9]; const float* lk2 = args.in[10];
    const float* subln_g = args.in[11]; const float* rel_bias = args.in[12];
    float* out = args.out;
    bf16* W0in = (bf16*)(ws + WS_W0IN); bf16* W0out = (bf16*)(ws + WS_W0OUT); bf16* XN = (bf16*)(ws + WS_XN);
    bf16* Q0 = (bf16*)(ws + WS_Q0); bf16* K0 = (bf16*)(ws + WS_K0); bf16* V0 = (bf16*)(ws + WS_V0); bf16* G0 = (bf16*)(ws + WS_G0);
    bf16* Q1 = (bf16*)(ws + WS_Q1); bf16* K1 = (bf16*)(ws + WS_K1); bf16* V1 = (bf16*)(ws + WS_V1);
    bf16* W1g = (bf16*)(ws + WS_W1G); bf16* W1out = (bf16*)(ws + WS_W1OUT);
    float* YF0 = (float*)(ws + WS_YF_L0); float* YF1 = (float*)(ws + WS_YF_L1);

    for (int u = F.tid; u < (LDS_BYTES - LDSCTL_OFF) / 4; u += NTHREADS) ((LAS unsigned*)(F.lds + LDSCTL_OFF))[u] = 0u;
    __syncthreads();
    XcdBarrier bar = xcd_barrier_post((unsigned*)(F.ctl + CW_BAR), F.MISC + 8);
#define GRID_BAR() xcd_barrier(bar)

    const int gw = F.vcu * NWAVES + F.wave, NGW = F.G * NWAVES;
    const int gtid = F.vcu * NTHREADS + F.tid, NT = F.G * NTHREADS;
    LAS float* scr = (LAS float*)(F.lds + RING_OFF + F.wave * 16384);

    for (int rep = 0; rep < 1 + PROBE_MISC; ++rep) {
    transpose_all(ret_w_in, DM, RET_COLS, W0in, 0, RET_COLS, scr, gw, NGW, F.lane);
    transpose_all(ret_w_out, DI, DM, W0out, 0, DM, scr, gw, NGW, F.lane);
    norm_rows(x, nullptr, nullptr, pre_g, nullptr, XN, 0, gw, NGW, F.lane); }
    GRID_BAR();

    {
        pg8::Gemm g{XN, W0in, MROWS, RET_COLS, DM}; pg8::StaticOrder S; S.init(MROWS, RET_COLS, F.G, (int)blockIdx.x);
        pg8::EpiRetIn<true> E{Q0, K0, V0, G0};
        for (int rep = 0; rep < 1 + PROBE_GEMM; ++rep)
            pg8::gemm_phase<pg8::EpiRetIn<true>, pg8::StaticOrder, PG8_ALIGN, PG8_SP2>(F.lds + RING_OFF, g, S, E);
    }
    GRID_BAR();

    {
        float* Ebuf = (float*)(ws + WS_XN);
        transpose_all(diff_w_in, DM, DIFF_COLS, W0in, 0, DIFF_QKV_COLS, scr, gw, NGW, F.lane);
        transpose_all(diff_w_in, DM, DIFF_COLS, W1g, DIFF_QKV_COLS, DIFF_COLS, scr, gw, NGW, F.lane);
        transpose_all(diff_w_out, DI, DM, W1out, 0, DM, scr, gw, NGW, F.lane);
        __syncthreads();
        for (int rep = 0; rep < 1 + PROBE_RET; ++rep) for (int u = F.vcu; u < 256; u += F.G) rt::ret_unit<false, true>(u, Q0, K0, V0, Ebuf, (LAS char*)(F.lds + RING_OFF));
        GRID_BAR();
        for (int rep = 0; rep < PROBE_RET; ++rep) for (int u = F.vcu; u < 256; u += F.G) rt::ret_unit<true, false>(u, Q0, K0, V0, Ebuf, (LAS char*)(F.lds + RING_OFF));
        for (int u = F.vcu; u < 256; u += F.G) rt::ret_unit<true, true>(u, Q0, K0, V0, Ebuf, (LAS char*)(F.lds + RING_OFF));
        GRID_BAR();
        gn_gate_rows(V0, G0, gw, NGW, F.lane);
    }
    GRID_BAR();

    {
        pg8::Gemm g{G0, W0out, MROWS, DM, DI}; pg8::StaticOrder S; S.init(MROWS, DM, F.G, (int)blockIdx.x);
        pg8::EpiF32 E{YF0, DM, 0};
        for (int rep = 0; rep < 1 + PROBE_GEMM; ++rep)
            pg8::gemm_phase<pg8::EpiF32, pg8::StaticOrder, PG8_ALIGN, PG8_SP2>(F.lds + RING_OFF, g, S, E);
    }
    GRID_BAR();
    for (int rep = 0; rep < 1 + PROBE_MISC; ++rep) norm_rows(YF0, x, post_g, pre_g + DM, out, XN, 1, gw, NGW, F.lane);
    GRID_BAR();

    {
        pg8::Gemm g{XN, W0in, MROWS, DIFF_QKV_COLS, DM}; pg8::StaticOrder S; S.init(MROWS, DIFF_QKV_COLS, F.G, (int)blockIdx.x);
        pg8::EpiBf16S E{Q1, (size_t)(WS_K1 - WS_Q1) / 2, DI, DI, QSCALE2, 0};
        for (int rep = 0; rep < 1 + PROBE_GEMM; ++rep)
            pg8::gemm_phase<pg8::EpiBf16S, pg8::StaticOrder, PG8_ALIGN, PG8_SP2>(F.lds + RING_OFF, g, S, E);
    }
    GRID_BAR();

    for (int rep = 0; rep < PROBE_ATT; ++rep) da::attn_phase<false, PROBE_ATT_MODE>((LAS char*)(F.lds + RING_OFF), Q1, K1, V1, lq1, lk1, lq2, lk2, subln_g, rel_bias, F.vcu, F.G);
    da::attn_phase<true>((LAS char*)(F.lds + RING_OFF), Q1, K1, V1, lq1, lk1, lq2, lk2, subln_g, rel_bias, F.vcu, F.G);
    GRID_BAR();

    {
        pg8::Gemm g{XN, W1g, MROWS, DI, DM}; pg8::StaticOrder S; S.init(MROWS, DI, F.G, (int)blockIdx.x);
        pg8::EpiGate E{Q1, DI, 0};
        for (int rep = 0; rep < PROBE_GEMM; ++rep) { pg8::EpiGateT<false> E2{Q1, DI, 0}; pg8::gemm_phase<pg8::EpiGateT<false>, pg8::StaticOrder, PG8_ALIGN, PG8_SP2>(F.lds + RING_OFF, g, S, E2); }
        pg8::gemm_phase<pg8::EpiGate, pg8::StaticOrder, PG8_ALIGN, PG8_SP2>(F.lds + RING_OFF, g, S, E);
    }
    GRID_BAR();

    {
        pg8::Gemm g{Q1, W1out, MROWS, DM, DI}; pg8::StaticOrder S; S.init(MROWS, DM, F.G, (int)blockIdx.x);
        pg8::EpiF32 E{YF1, DM, 0};
        for (int rep = 0; rep < 1 + PROBE_GEMM; ++rep)
            pg8::gemm_phase<pg8::EpiF32, pg8::StaticOrder, PG8_ALIGN, PG8_SP2>(F.lds + RING_OFF, g, S, E);
    }
    GRID_BAR();
    norm_rows(YF1, out, post_g + DM, nullptr, out, nullptr, 2, gw, NGW, F.lane);
}

extern "C" void kernel_launch(void* const* d_in, const int* in_sizes, int n_in, void* d_out, int out_size, void* d_ws, size_t ws_size, hipStream_t stream) {
    static int grid = 0;
    if (grid == 0) {
        if (n_in != 13 || out_size != MROWS * DM || ws_size < WS_END) { fprintf(stderr, "kernel_launch: unexpected shapes (n_in %d out %d ws %zu)\n", n_in, out_size, ws_size); grid = -1; return; }
        int dev = 0, cus = 0, per_cu = 0;
        if (hipGetDevice(&dev) != hipSuccess || hipDeviceGetAttribute(&cus, hipDeviceAttributeMultiprocessorCount, dev) != hipSuccess) { grid = -1; return; }
        if (hipFuncSetAttribute((const void*)mega_fwd, hipFuncAttributeMaxDynamicSharedMemorySize, LDS_BYTES) != hipSuccess) { fprintf(stderr, "kernel_launch: hipFuncSetAttribute failed\n"); grid = -1; return; }
        if (hipOccupancyMaxActiveBlocksPerMultiprocessor(&per_cu, (const void*)mega_fwd, NTHREADS, LDS_BYTES) != hipSuccess || per_cu < 1)
            fprintf(stderr, "kernel_launch: occupancy query reports %d workgroups per CU\n", per_cu);
        (void)hipGetLastError();
        grid = cus;
        if (grid != 256) fprintf(stderr, "kernel_launch: %d CUs (built for 256)\n", grid);
    }
    if (grid < 0) return;
    if (hipMemsetAsync((char*)d_ws + WS_CTL, 0, CTL_ZERO_BYTES, stream) != hipSuccess) { fprintf(stderr, "kernel_launch: memset failed\n"); return; }
    Args a; memset(&a, 0, sizeof(a));
    for (int i = 0; i < 13; ++i) a.in[i] = (const float*)d_in[i];
    a.out = (float*)d_out; a.ws = (unsigned char*)d_ws; a.ph_lo = 0; a.ph_hi = 100;
    hipLaunchKernelGGL(mega_fwd, dim3(grid), dim3(NTHREADS), LDS_BYTES, stream, a);
}
```
